# Optimizing an MI355X kernel written in HIP

```python
import jax, jax.numpy as jnp
from jax import lax
import numpy as np

D_MODEL = 1024
BATCH = 2
SEQ = 8192
DEPTH = 1
DEC_BATCH = 16
DEC_SEQ = 64
PAST_LEN = 1024

CHUNK = 64
Q_BLOCK = 128
HEAD_DIM = 64
N_SB_HEADS = 8
N_FOX_HEADS = 8
SB_WIDTH = N_SB_HEADS * HEAD_DIM
FOX_WIDTH = N_FOX_HEADS * HEAD_DIM
MIX_WIDTH = SB_WIDTH + FOX_WIDTH
IN_COLS = 3 * SB_WIDTH + 3 * FOX_WIDTH + N_FOX_HEADS
D_FF = -(-8 * D_MODEL // (3 * 256)) * 256
EPS = 1e-6
SPLITS = [SB_WIDTH, 2 * SB_WIDTH, 3 * SB_WIDTH,
          3 * SB_WIDTH + FOX_WIDTH, 3 * SB_WIDTH + 2 * FOX_WIDTH, 3 * SB_WIDTH + 3 * FOX_WIDTH]

kernel_name = "stickbreak_forgetting_hybrid_stream_step"


def rmsnorm(x, g):
    xf = x.astype(jnp.float32)
    y = xf * lax.rsqrt(jnp.mean(xf * xf, axis=-1, keepdims=True) + EPS)
    return (y * g.astype(jnp.float32)).astype(x.dtype)


def ada_terms(c, w_ada, b_ada):
    a = jax.nn.silu(c) @ w_ada + b_ada
    return [t[:, None, :] for t in jnp.split(a, 6, axis=-1)]


def sb_attend(q, k, v, q_pos, k_pos):
    z = jnp.einsum('bqhd,bkhd->bhqk', q.astype(jnp.float32), k.astype(jnp.float32)) * (HEAD_DIM ** -0.5)
    mask = k_pos[None, :] < q_pos[:, None]
    log_keep = jnp.where(mask, jax.nn.log_sigmoid(-z), 0.0)
    between = lax.cumsum(log_keep, axis=3, reverse=True) - log_keep
    a = jnp.where(mask, jnp.exp(jax.nn.log_sigmoid(z) + between), 0.0)
    return jnp.einsum('bhqk,bkhd->bqhd', a, v.astype(jnp.float32)).astype(v.dtype)


def fox_attend(q, k, v, fq, fk, q_pos, k_pos):
    s = jnp.einsum('bqhd,bkhd->bhqk', q.astype(jnp.float32), k.astype(jnp.float32)) * (HEAD_DIM ** -0.5)
    s = s + jnp.transpose(fq, (0, 2, 1))[:, :, :, None] - jnp.transpose(fk, (0, 2, 1))[:, :, None, :]
    mask = k_pos[None, :] <= q_pos[:, None]
    p = jax.nn.softmax(jnp.where(mask, s, -jnp.inf), axis=-1)
    return jnp.einsum('bhqk,bkhd->bqhd', p, v.astype(jnp.float32)).astype(v.dtype)


def to_blocks(a):
    b, t = a.shape[0], a.shape[1]
    return jnp.swapaxes(a.reshape((b, t // Q_BLOCK, Q_BLOCK) + a.shape[2:]), 0, 1)


def from_blocks(a):
    nb, b = a.shape[0], a.shape[1]
    return jnp.swapaxes(a, 0, 1).reshape((b, nb * Q_BLOCK) + a.shape[3:])


def sb_prompt(q, k, v):
    pos = jnp.arange(q.shape[1], dtype=jnp.int32)
    out = lax.map(lambda a: sb_attend(a[0], k, v, a[1], pos), (to_blocks(q), pos.reshape(-1, Q_BLOCK)))
    return from_blocks(out)


def fox_prompt(q, k, v, f):
    pos = jnp.arange(q.shape[1], dtype=jnp.int32)
    out = lax.map(lambda a: fox_attend(a[0], k, v, a[1], f, a[2], pos),
                  (to_blocks(q), to_blocks(f), pos.reshape(-1, Q_BLOCK)))
    return from_blocks(out)


def pre_mixer(x, shift, scale, g_mix, w_in, b_f):
    b, t, _ = x.shape
    h = rmsnorm(x, g_mix) * (1.0 + scale) + shift
    parts = jnp.split(h @ w_in, SPLITS, axis=-1)
    q_sb, k_sb, v_sb = [p.reshape(b, t, N_SB_HEADS, HEAD_DIM) for p in parts[0:3]]
    q_fx, k_fx, v_fx = [p.reshape(b, t, N_FOX_HEADS, HEAD_DIM) for p in parts[3:6]]
    logf = jax.nn.log_sigmoid((parts[6] + b_f).astype(jnp.float32))
    return q_sb, k_sb, v_sb, q_fx, k_fx, v_fx, logf


def post_mixer(x, o_sb, o_fx, ada, g_sb_out, g_fox_out, w_o, g_ffn, w_gate, w_up, w_down):
    b, t, _ = x.shape
    o = jnp.concatenate([rmsnorm(o_sb.reshape(b, t, SB_WIDTH), g_sb_out),
                         rmsnorm(o_fx.reshape(b, t, FOX_WIDTH), g_fox_out)], axis=-1)
    x = x + (1.0 + ada[2]) * (o @ w_o)
    h = rmsnorm(x, g_ffn) * (1.0 + ada[4]) + ada[3]
    f = (jax.nn.silu(h @ w_gate) * (h @ w_up)) @ w_down
    return x + (1.0 + ada[5]) * f


def setup_inputs(seed: int = 0) -> dict:
    key = jax.random.key(seed)
    ks = jax.random.split(key, 24)
    f32 = jnp.float32
    nrm = lambda k, shape, s=1.0: (jax.random.normal(k, shape, f32) * s)
    return {
        "x_prompt": nrm(ks[0], (BATCH, SEQ, D_MODEL)),
        "x_sample": nrm(ks[1], (DEC_BATCH, DEC_SEQ, D_MODEL)),
        "c_prompt": nrm(ks[2], (BATCH, D_MODEL)),
        "c_sample": nrm(ks[3], (DEC_BATCH, D_MODEL)),
        "cache_sb_k": nrm(ks[4], (DEPTH, DEC_BATCH, PAST_LEN, N_SB_HEADS, HEAD_DIM)),
        "cache_sb_v": nrm(ks[5], (DEPTH, DEC_BATCH, PAST_LEN, N_SB_HEADS, HEAD_DIM)),
        "cache_fox_k": nrm(ks[6], (DEPTH, DEC_BATCH, PAST_LEN, N_FOX_HEADS, HEAD_DIM)),
        "cache_fox_v": nrm(ks[7], (DEPTH, DEC_BATCH, PAST_LEN, N_FOX_HEADS, HEAD_DIM)),
        "cache_fox_logf": jax.nn.log_sigmoid(nrm(ks[8], (DEPTH, DEC_BATCH, PAST_LEN, N_FOX_HEADS)) + 3.0),
        "w_ada": nrm(ks[9], (DEPTH, D_MODEL, 6 * D_MODEL), 0.1 * D_MODEL ** -0.5),
        "b_ada": nrm(ks[10], (DEPTH, 6 * D_MODEL), 0.01),
        "g_mix": 1.0 + nrm(ks[11], (DEPTH, D_MODEL), 0.05),
        "w_in": nrm(ks[12], (DEPTH, D_MODEL, IN_COLS), D_MODEL ** -0.5),
        "b_f": 1.0 + 3.0 * jax.random.uniform(ks[13], (DEPTH, N_FOX_HEADS), f32),
        "g_sb_out": 1.0 + nrm(ks[14], (DEPTH, SB_WIDTH), 0.05),
        "g_fox_out": 1.0 + nrm(ks[15], (DEPTH, FOX_WIDTH), 0.05),
        "w_o": nrm(ks[16], (DEPTH, MIX_WIDTH, D_MODEL), MIX_WIDTH ** -0.5),
        "g_ffn": 1.0 + nrm(ks[17], (DEPTH, D_MODEL), 0.05),
        "w_gate": nrm(ks[18], (DEPTH, D_MODEL, D_FF), D_MODEL ** -0.5),
        "w_up": nrm(ks[19], (DEPTH, D_MODEL, D_FF), D_MODEL ** -0.5),
        "w_down": nrm(ks[20], (DEPTH, D_FF, D_MODEL), D_FF ** -0.5),
        "g_final": 1.0 + nrm(ks[21], (D_MODEL,), 0.05),
    }


def reference(x_prompt, x_sample, c_prompt, c_sample, cache_sb_k, cache_sb_v, cache_fox_k,
              cache_fox_v, cache_fox_logf, w_ada, b_ada, g_mix, w_in, b_f, g_sb_out, g_fox_out,
              w_o, g_ffn, w_gate, w_up, w_down, g_final):
    xp, xs = x_prompt, x_sample
    n_new = xs.shape[1]
    past = cache_sb_k.shape[2]
    q_pos_s = past + jnp.arange(n_new, dtype=jnp.int32)
    k_pos_s = jnp.arange(past + n_new, dtype=jnp.int32)
    sbk_p, sbv_p, fxk_p, fxv_p, lf_p = [], [], [], [], []
    sbk_s, sbv_s, fxk_s, fxv_s, lf_s = [], [], [], [], []
    for l in range(DEPTH):
        ada_p = ada_terms(c_prompt, w_ada[l], b_ada[l])
        q_sb, k_sb, v_sb, q_fx, k_fx, v_fx, logf = pre_mixer(xp, ada_p[0], ada_p[1], g_mix[l], w_in[l], b_f[l])
        o_sb = sb_prompt(q_sb, k_sb, v_sb)
        f_cum = jnp.cumsum(logf, axis=1)
        o_fx = fox_prompt(q_fx, k_fx, v_fx, f_cum)
        xp = post_mixer(xp, o_sb, o_fx, ada_p, g_sb_out[l], g_fox_out[l], w_o[l], g_ffn[l],
                        w_gate[l], w_up[l], w_down[l])
        sbk_p.append(k_sb); sbv_p.append(v_sb); fxk_p.append(k_fx); fxv_p.append(v_fx)
        lf_p.append(logf.astype(x_prompt.dtype))
        ada_s = ada_terms(c_sample, w_ada[l], b_ada[l])
        q_sb, k_sb, v_sb, q_fx, k_fx, v_fx, logf = pre_mixer(xs, ada_s[0], ada_s[1], g_mix[l], w_in[l], b_f[l])
        k_all = jnp.concatenate([cache_sb_k[l], k_sb], axis=1)
        v_all = jnp.concatenate([cache_sb_v[l], v_sb], axis=1)
        o_sb = sb_attend(q_sb, k_all, v_all, q_pos_s, k_pos_s)
        f_all = jnp.cumsum(jnp.concatenate([cache_fox_logf[l].astype(jnp.float32), logf], axis=1), axis=1)
        kf_all = jnp.concatenate([cache_fox_k[l], k_fx], axis=1)
        vf_all = jnp.concatenate([cache_fox_v[l], v_fx], axis=1)
        o_fx = fox_attend(q_fx, kf_all, vf_all, f_all[:, past:], f_all, q_pos_s, k_pos_s)
        xs = post_mixer(xs, o_sb, o_fx, ada_s, g_sb_out[l], g_fox_out[l], w_o[l], g_ffn[l],
                        w_gate[l], w_up[l], w_down[l])
        sbk_s.append(k_sb); sbv_s.append(v_sb); fxk_s.append(k_fx); fxv_s.append(v_fx)
        lf_s.append(logf.astype(x_sample.dtype))
    y_prompt = rmsnorm(xp, g_final)
    y_sample = rmsnorm(xs, g_final)
    return (y_prompt, y_sample,
            jnp.stack(sbk_p), jnp.stack(sbv_p), jnp.stack(fxk_p), jnp.stack(fxv_p), jnp.stack(lf_p),
            jnp.stack(sbk_s), jnp.stack(sbv_s), jnp.stack(fxk_s), jnp.stack(fxv_s), jnp.stack(lf_s))
```

```cpp
#include <hip/hip_runtime.h>
#include <hip/hip_cooperative_groups.h>
#include <cstdio>
#include <cstdint>
namespace cg = cooperative_groups;
namespace pg8 {
#define PG8_LAS __attribute__((address_space(3)))
typedef unsigned short bf16_t;
typedef short bf16x8 __attribute__((ext_vector_type(8)));
typedef float f32x4 __attribute__((ext_vector_type(4)));
typedef unsigned u32x4 __attribute__((ext_vector_type(4)));
constexpr int BM = 256, BK = 64, HALF = 128, HTB = HALF * BK * 2  , STAGE_BYTES = 8 * HTB, NXCD = 8, WGM = 8;

__host__ __device__ __forceinline__ int lds_byte(int r, int c) { const int st = (r >> 4) * 2 + (c >> 5), rr = r & 15, cc = c & 31, ob = rr * 64 + cc * 2; return st * 1024 + (ob ^ (((ob >> 9) & 1) << 5)); }
__host__ __device__ __forceinline__ void stage_rc(int b, int& R, int& C) { const int st = b / 1024, sb = b % 1024, swz = sb ^ (((sb >> 9) & 1) << 5); R = (st >> 1) * 16 + swz / 64; C = (st & 1) * 32 + (swz % 64) / 2; }
__host__ __device__ __forceinline__ int perm32(int rho) { const int n = rho >> 4, i = rho & 15; return 8 * (i >> 2) + 4 * n + (i & 3); }

struct Unit { int pm, pn, koff, nt; };
struct Gemm { const bf16_t* A; const bf16_t* Bt; int M, N, K; };

struct StaticOrder {
    int nM, nN, nwg, G, c, ntf;
    __host__ __device__ __forceinline__ void init(int M, int N, int G_, int c_, int K_) { nM = M / BM; nN = N / BM; nwg = nM * nN; G = G_; c = c_; ntf = K_ / BK; }
    __host__ __device__ __forceinline__ bool next(int i, Unit& u) const {
        const long L = (long)i * G + c; if (L >= nwg) return false;
        int wgid = (int)L; { const int q = nwg / NXCD, r = nwg % NXCD, xcd = wgid % NXCD, off = wgid / NXCD; wgid = (xcd < r ? xcd * (q + 1) : r * (q + 1) + (xcd - r) * q) + off; }
        const int nig = WGM * nN, gid = wgid / nig, fm = gid * WGM, gsz = (nM - fm) < WGM ? (nM - fm) : WGM;
        u.pm = fm + ((wgid % nig) % gsz); u.pn = (wgid % nig) / gsz; u.koff = 0; u.nt = ntf; return true;
    }
    __device__ __forceinline__ void a_ready(const Unit&) const {}
    __device__ __forceinline__ void done(const Unit&) const {}
};

template <class Epi, class Sched, bool ALIGN_EPI = false, bool SP2 = false>
__device__ __forceinline__ void gemm_phase(PG8_LAS unsigned char* lds, const Gemm g, const Sched& S, const Epi& E) {
    const int tid = threadIdx.x, wid = __builtin_amdgcn_readfirstlane(tid >> 6), lane = tid & 63, wr = wid >> 2, wc = wid & 3, fr = lane & 15, fq = lane >> 4;
    const int K = g.K;
    unsigned voffA[2], voffB[2];
#pragma unroll
    for (int i = 0; i < 2; ++i) { int R, C; stage_rc(tid * 16 + i * 8192, R, C); const int Rb = Epi::PERM ? ((R & ~31) + perm32(R & 31)) : R;
        voffA[i] = (unsigned)(R * K + C) * 2u; voffB[i] = (unsigned)(Rb * K + C) * 2u; }
    const size_t kstep = (size_t)(BK * 2);
    const size_t hstep = (size_t)HALF * K * 2;
    const size_t tstep = 2 * hstep;
    const unsigned ldsw = (unsigned)wid * 1024u;
    const int aoff = lds_byte(wr * 64 + fr, fq * 8), boff = lds_byte(wc * 32 + fr, fq * 8);
#define PG8_SA(b, h) (((b) * 2 + (h)) * HTB)
#define PG8_SB(b, h) ((4 + (b) * 2 + (h)) * HTB)
#define PG8_STAGE(bufoff, gbase, voff) do { _Pragma("unroll") for (int _i = 0; _i < 2; ++_i) \
        __builtin_amdgcn_global_load_lds((const unsigned*)((const char*)(gbase) + (voff)[_i]), (PG8_LAS unsigned*)(lds + (bufoff) + ldsw + _i * 8192), 16, 0, 0); } while (0)
#define PG8_LDA(dst, b, h) do { _Pragma("unroll") for (int m = 0; m < 4; ++m) _Pragma("unroll") for (int k = 0; k < 2; ++k) dst[m][k] = *(const PG8_LAS bf16x8*)(lds + PG8_SA(b, h) + aoff + m * 2048 + k * 1024); } while (0)
#define PG8_LDB(dst, b, h) do { _Pragma("unroll") for (int n = 0; n < 2; ++n) _Pragma("unroll") for (int k = 0; k < 2; ++k) dst[n][k] = *(const PG8_LAS bf16x8*)(lds + PG8_SB(b, h) + boff + n * 2048 + k * 1024); } while (0)
#define PG8_MMA(ai, bj, At, Bt) do { __builtin_amdgcn_s_setprio(1); _Pragma("unroll") for (int m = 0; m < 4; ++m) _Pragma("unroll") for (int n = 0; n < 2; ++n) _Pragma("unroll") for (int k = 0; k < 2; ++k) \
        acc[ai][bj][m][n] = __builtin_amdgcn_mfma_f32_16x16x32_bf16(Bt[n][k], At[m][k], acc[ai][bj][m][n], 0, 0, 0); __builtin_amdgcn_s_setprio(0); } while (0)
#define PG8_WAIT_V(n) asm volatile("s_waitcnt vmcnt(" #n ")" ::: "memory")
#define PG8_WAIT_L(n) asm volatile("s_waitcnt lgkmcnt(" #n ")" ::: "memory")
#define PG8_BAR __builtin_amdgcn_s_barrier()
#define PG8_SCHED __builtin_amdgcn_sched_barrier(0)
    Unit cur, nxt; int ui = 0;
    if (!S.next(0, cur)) return;
    f32x4 acc[2][2][4][2];
#pragma unroll
    for (int a = 0; a < 2; ++a)
#pragma unroll
        for (int b = 0; b < 2; ++b)
#pragma unroll
            for (int m = 0; m < 4; ++m)
#pragma unroll
                for (int n = 0; n < 2; ++n) acc[a][b][m][n] = (f32x4){0.f, 0.f, 0.f, 0.f};
    bf16x8 At[4][2], B0[2][2], B1[2][2];
    const char* cA = (const char*)g.A + (size_t)cur.pm * tstep + (size_t)cur.koff * 2; const char* cB = (const char*)g.Bt + (size_t)cur.pn * tstep + (size_t)cur.koff * 2;
    S.a_ready(cur);
    if constexpr (SP2) {
        PG8_STAGE(PG8_SB(0, 0), cB, voffB); PG8_STAGE(PG8_SB(0, 1), cB + hstep, voffB); PG8_STAGE(PG8_SA(0, 0), cA, voffA); PG8_STAGE(PG8_SA(0, 1), cA + hstep, voffA);
        if (wr == 1) PG8_BAR;
        PG8_WAIT_V(2); PG8_BAR;
        PG8_STAGE(PG8_SB(1, 0), cB + kstep, voffB); PG8_STAGE(PG8_SA(1, 0), cA + kstep, voffA); PG8_STAGE(PG8_SB(1, 1), cB + hstep + kstep, voffB);
        PG8_WAIT_V(6); PG8_BAR;
    } else {
        PG8_STAGE(PG8_SB(0, 0), cB, voffB); PG8_STAGE(PG8_SA(0, 0), cA, voffA); PG8_STAGE(PG8_SB(0, 1), cB + hstep, voffB); PG8_STAGE(PG8_SA(0, 1), cA + hstep, voffA);
        if (wr == 1) PG8_BAR;
        PG8_WAIT_V(4); PG8_BAR;
        PG8_STAGE(PG8_SB(1, 0), cB + kstep, voffB); PG8_STAGE(PG8_SA(1, 0), cA + kstep, voffA); PG8_STAGE(PG8_SB(1, 1), cB + hstep + kstep, voffB);
        PG8_WAIT_V(6); PG8_BAR;
    }
    for (;;) {
        const bool has_next = S.next(ui + 1, nxt);
        const char* nA = has_next ? (const char*)g.A + (size_t)nxt.pm * tstep + (size_t)nxt.koff * 2 : cA; const char* nB = has_next ? (const char*)g.Bt + (size_t)nxt.pn * tstep + (size_t)nxt.koff * 2 : cB;
        const int nt = cur.nt;
        for (int t = 0; t < nt; t += 2) {
            const bool last = (t == nt - 2);
            if constexpr (Epi::MIDK) { if (t == Epi::MIDT && cur.pm < Epi::MIDPM) E.mid(acc, cur, wr, wc, fr, fq); }
            const char* a1 = cA + (size_t)(t + 1) * kstep;
            const char* a2 = last ? nA : cA + (size_t)(t + 2) * kstep; const char* b2 = last ? nB : cB + (size_t)(t + 2) * kstep;
            const char* a3 = a2 + kstep; const char* b3 = b2 + kstep;
            if (last && has_next) S.a_ready(nxt);
            if constexpr (SP2) {
            PG8_LDB(B0, 0, 0); PG8_LDB(B1, 0, 1); PG8_SCHED; PG8_LDA(At, 0, 0); PG8_STAGE(PG8_SA(1, 1), a1 + hstep, voffA);
            PG8_WAIT_V(8); PG8_WAIT_L(0); PG8_BAR; PG8_MMA(0, 0, At, B0); PG8_MMA(0, 1, At, B1); PG8_BAR; PG8_SCHED;
            PG8_LDA(At, 0, 1); PG8_STAGE(PG8_SB(0, 0), b2, voffB); PG8_STAGE(PG8_SB(0, 1), b2 + hstep, voffB); PG8_STAGE(PG8_SA(0, 0), a2, voffA);
            PG8_WAIT_V(8); PG8_WAIT_L(0); PG8_BAR; PG8_MMA(1, 0, At, B0); PG8_MMA(1, 1, At, B1); PG8_BAR; PG8_SCHED;
            PG8_LDB(B0, 1, 0); PG8_LDB(B1, 1, 1); PG8_SCHED; PG8_LDA(At, 1, 0); PG8_STAGE(PG8_SA(0, 1), a2 + hstep, voffA);
            PG8_WAIT_V(8); PG8_WAIT_L(0); PG8_BAR; PG8_MMA(0, 0, At, B0); PG8_MMA(0, 1, At, B1); PG8_BAR; PG8_SCHED;
            PG8_LDA(At, 1, 1); PG8_STAGE(PG8_SB(1, 0), b3, voffB); PG8_STAGE(PG8_SB(1, 1), b3 + hstep, voffB); PG8_STAGE(PG8_SA(1, 0), a3, voffA);
            PG8_WAIT_V(8); PG8_WAIT_L(0); PG8_BAR; PG8_MMA(1, 0, At, B0); PG8_MMA(1, 1, At, B1); PG8_BAR; PG8_SCHED;
            } else {
            PG8_LDB(B0, 0, 0); PG8_SCHED; PG8_LDA(At, 0, 0); PG8_STAGE(PG8_SA(1, 1), a1 + hstep, voffA);
            PG8_WAIT_L(8); PG8_BAR; PG8_WAIT_L(0); PG8_MMA(0, 0, At, B0); PG8_BAR; PG8_SCHED;
            PG8_LDB(B1, 0, 1); PG8_STAGE(PG8_SB(0, 0), b2, voffB);
            PG8_BAR; PG8_WAIT_L(0); PG8_MMA(0, 1, At, B1); PG8_BAR;
            PG8_LDA(At, 0, 1); PG8_STAGE(PG8_SA(0, 0), a2, voffA);
            PG8_BAR; PG8_WAIT_L(0); PG8_MMA(1, 0, At, B0); PG8_BAR; PG8_SCHED;
            PG8_STAGE(PG8_SB(0, 1), b2 + hstep, voffB);
            PG8_WAIT_V(6); PG8_BAR; PG8_MMA(1, 1, At, B1); PG8_BAR;
            PG8_LDB(B0, 1, 0); PG8_SCHED; PG8_LDA(At, 1, 0); PG8_STAGE(PG8_SA(0, 1), a2 + hstep, voffA);
            PG8_WAIT_L(8); PG8_BAR; PG8_WAIT_L(0); PG8_MMA(0, 0, At, B0); PG8_BAR; PG8_SCHED;
            PG8_LDB(B1, 1, 1); PG8_STAGE(PG8_SB(1, 0), b3, voffB);
            PG8_BAR; PG8_WAIT_L(0); PG8_MMA(0, 1, At, B1); PG8_BAR;
            PG8_LDA(At, 1, 1); PG8_STAGE(PG8_SA(1, 0), a3, voffA);
            PG8_BAR; PG8_WAIT_L(0); PG8_MMA(1, 0, At, B0); PG8_BAR; PG8_SCHED;
            PG8_STAGE(PG8_SB(1, 1), b3 + hstep, voffB);
            PG8_WAIT_V(6); PG8_BAR; PG8_MMA(1, 1, At, B1); PG8_BAR;
            }
        }
        if constexpr (ALIGN_EPI) { if (wr == 0) PG8_BAR; }
        if constexpr (!Epi::AFTER_DRAIN) { E(acc, cur, wr, wc, fr, fq); S.done(cur); }
        if (!has_next) break;
#pragma unroll
        for (int a = 0; a < 2; ++a)
#pragma unroll
            for (int b = 0; b < 2; ++b)
#pragma unroll
                for (int m = 0; m < 4; ++m)
#pragma unroll
                    for (int n = 0; n < 2; ++n) acc[a][b][m][n] = (f32x4){0.f, 0.f, 0.f, 0.f};
        cur = nxt; cA = nA; cB = nB; ++ui;
        if constexpr (ALIGN_EPI) { if (wr == 1) PG8_BAR; }
    }
    PG8_WAIT_V(0);
    if constexpr (!ALIGN_EPI) { if (wr == 0) PG8_BAR; }
    PG8_BAR;
    if constexpr (Epi::AFTER_DRAIN) { E.fused(acc, cur, wr, wc, fr, fq, lds, wid, lane); S.done(cur); }
#undef PG8_SA
#undef PG8_SB
#undef PG8_STAGE
#undef PG8_LDA
#undef PG8_LDB
#undef PG8_MMA
#undef PG8_WAIT_V
#undef PG8_WAIT_L
#undef PG8_BAR
#undef PG8_SCHED
}
}

#ifndef REP_ATT
#define REP_ATT 1
#endif
#ifndef REP_GEMM
#define REP_GEMM 1
#endif
#ifndef MK_MULTI
#define MK_MULTI 0
#endif
namespace mk {
using pg8::bf16_t; using pg8::bf16x8; using pg8::f32x4; using pg8::u32x4;
typedef float f32x16 __attribute__((ext_vector_type(16)));
typedef unsigned u32x2 __attribute__((ext_vector_type(2)));
#define LAS __attribute__((address_space(3)))
#define DI __device__ __forceinline__

#define XB_TMO      128
#define XB_XCNT(j)  (256  + 64 * (j))
#define XB_XSUB(j)  (1280 + 64 * (j))
#define XB_XGEN(j)  (2304 + 64 * (j))
#define XB_TOP      3328
#define XB_TOPGEN   3392
#define XCD_BAR_WORDS 3456
#define XB_SPIN_CAP (1u << 18)

__device__ __forceinline__ unsigned xb_ld(unsigned* p)              { return __hip_atomic_load(p, __ATOMIC_RELAXED, __HIP_MEMORY_SCOPE_AGENT); }
__device__ __forceinline__ unsigned xb_add(unsigned* p, unsigned v) { return __hip_atomic_fetch_add(p, v, __ATOMIC_RELAXED, __HIP_MEMORY_SCOPE_AGENT); }
__device__ __forceinline__ unsigned xb_xcc_id() { return (unsigned)__builtin_amdgcn_s_getreg((3 << 11) | 20) & 0xFu; }
#define XB_SPIN(cond, bar) do { unsigned _sp = 0; while (cond) { __builtin_amdgcn_s_sleep(1); \
    if ((++_sp & 255u) == 0u) { if (xb_ld(&(bar)[XB_TMO])) break; if (_sp > XB_SPIN_CAP) { atomicAdd(&(bar)[XB_TMO], 1u); break; } } } } while (0)

struct XcdBarrier {
    unsigned* bar; unsigned x;
    volatile LAS unsigned* st;
};

__device__ __forceinline__ XcdBarrier xcd_barrier_post(unsigned* bar, volatile LAS unsigned* st) {
    XcdBarrier b; b.bar = bar; b.x = xb_xcc_id(); b.st = st;
    if (threadIdx.x == 0) (void)xb_add(&bar[XB_XCNT(b.x)], 1u);
    return b;
}
__device__ __forceinline__ void xcd_barrier_complete(unsigned* bar, unsigned x, unsigned& nloc, unsigned& nx) {
    const unsigned G = gridDim.x * gridDim.y * gridDim.z;
    unsigned sum, cnt, mine, sp = 0u;
    for (;;) {
        sum = 0u; cnt = 0u; mine = 0u;
#pragma unroll
        for (unsigned j = 0; j < 16; ++j) { const unsigned c = xb_ld(&bar[XB_XCNT(j)]); sum += c; cnt += (c > 0u) ? 1u : 0u; mine = (j == x) ? c : mine; }
        if (sum == G) break;
        __builtin_amdgcn_s_sleep(1);
        if ((++sp & 255u) == 0u) { if (xb_ld(&bar[XB_TMO])) break; if (sp > XB_SPIN_CAP) { atomicAdd(&bar[XB_TMO], 1u); break; } }
    }
    nloc = mine > 0u ? mine : 1u; nx = cnt > 0u ? cnt : 1u;
}

__device__ __forceinline__ void xcd_barrier(const XcdBarrier& b) {
    asm volatile("s_waitcnt vmcnt(0)" ::: "memory");
    __syncthreads();
    if (threadIdx.x == 0) {
        unsigned* bar = b.bar;
        __builtin_amdgcn_s_waitcnt(0);
        unsigned nloc = b.st[0], nx = b.st[1];
        if (nloc == 0u) { xcd_barrier_complete(bar, b.x, nloc, nx); b.st[0] = nloc; b.st[1] = nx; }
        const unsigned old = xb_add(&bar[XB_XSUB(b.x)], 1u);
        const unsigned gen = old / nloc;
        if (old + 1u == (gen + 1u) * nloc) {
            __builtin_amdgcn_fence(__ATOMIC_RELEASE, "agent");
            asm volatile("s_waitcnt vmcnt(0)" ::: "memory");
            const unsigned og = xb_add(&bar[XB_TOP], 1u);
            const unsigned tg = og / nx;
            if (og + 1u == (tg + 1u) * nx) xb_add(&bar[XB_TOPGEN], 1u);
            else XB_SPIN(xb_ld(&bar[XB_TOPGEN]) == tg, bar);
            __builtin_amdgcn_fence(__ATOMIC_ACQUIRE, "agent");
            xb_add(&bar[XB_XGEN(b.x)], 1u);
            asm volatile("s_waitcnt vmcnt(0)" ::: "memory");
        } else {
            XB_SPIN(xb_ld(&bar[XB_XGEN(b.x)]) == gen, bar);
            __builtin_amdgcn_fence(__ATOMIC_ACQUIRE, "agent");
            asm volatile("s_waitcnt vmcnt(0)" ::: "memory");
        }
    }
    __syncthreads();
}

constexpr int MP = 16384, MS = 1024, M = MP + MS, D = 1024, NIN = 3080, NINP = 3328, DFF = 2816, TS = 1088, TP = 8192;
constexpr float LOG2E = 1.4426950408889634f, C2 = 0.125f * LOG2E, EPS = 1e-6f;
constexpr size_t O_YP = 0, O_YS = 16777216, O_SBKP = 17825792, O_LFP = 51380224, O_SBKS = 51511296, O_LFS = 53608448;
constexpr size_t KVP_SZ = 8388608, KVS_SZ = 524288;
constexpr size_t MiB = 1u << 20;
constexpr size_t WS_ADA = 0, ADA_BYTES = 18 * 6144 * 4, WS_BAR = 512 * 1024, WS_KMAX = WS_BAR + 16384, WS_CTR = WS_KMAX + 256, CTL_BYTES = WS_CTR + 256;
constexpr size_t WS_FCP = 1 * MiB, WS_FCS = 2 * MiB, WS_SS = 3 * MiB;
constexpr size_t WS_WIN = 5 * MiB, WS_WO = 12 * MiB, WS_WGU = 14 * MiB, WS_WD = 25 * MiB;
constexpr size_t WS_HN = 32 * MiB, WS_QB = 66 * MiB, WS_KP = 100 * MiB, WS_VP = 132 * MiB, WS_KS = 164 * MiB, WS_VS = 198 * MiB;
constexpr size_t WS_HFF = 66 * MiB;
constexpr size_t WS_X1 = 188 * MiB;
static_assert(WS_KP == 100 * MiB && WS_VP == 132 * MiB && WS_KS == 164 * MiB && WS_VS == 198 * MiB && WS_HFF + (size_t)M * DFF * 2 <= WS_X1 && WS_X1 + (size_t)M * D * 4 <= 256 * MiB, "ws map");
constexpr int LDS_BYTES = 135168;

DI unsigned pk2(float lo, float hi) { typedef float f2 __attribute__((ext_vector_type(2))); typedef __bf16 b2 __attribute__((ext_vector_type(2))); f2 v = {lo, hi}; b2 b = __builtin_convertvector(v, b2); return __builtin_bit_cast(unsigned, b); }
DI float bf2f(unsigned short b) { return __uint_as_float((unsigned)b << 16); }
DI float ex2(float x) { return __builtin_amdgcn_exp2f(x); }
DI float lg2(float x) { return __builtin_amdgcn_logf(x); }
DI float wave_sum(float v) {
#pragma unroll
    for (int o = 1; o < 64; o <<= 1) v += __shfl_xor(v, o);
    return v;
}
DI int row_batch(int row) { return row < MP ? (row >> 13) : 2 + ((row - MP) >> 6); }
DI float logsig(float x) { return fminf(x, 0.f) - log1pf(expf(-fabsf(x))); }

struct EpiIn {
    static constexpr bool PERM = false, AFTER_DRAIN = false, MIDK = false;
    float* out; bf16_t* Qb; unsigned char* ws; const float* b_f;
    DI void operator()(const f32x4 (&acc)[2][2][4][2], const pg8::Unit& u, int wr, int wc, int fr, int fq) const {
        const int pn = u.pn, type = pn >> 1, half = (pn & 1) * 256;
        if (type == 6) {
            if (wc == 0 && fq < 2) {
                const f32x4 bf = *(const f32x4*)(b_f + fq * 4);
#pragma unroll
                for (int ai = 0; ai < 2; ++ai)
#pragma unroll
                    for (int m = 0; m < 4; ++m) {
                        const int row = u.pm * 256 + ai * 128 + wr * 64 + m * 16 + fr;
                        const f32x4 v = acc[ai][0][m][0] + bf;
                        f32x4 lf; lf[0] = logsig(v[0]); lf[1] = logsig(v[1]); lf[2] = logsig(v[2]); lf[3] = logsig(v[3]);
                        float* dst = row < MP ? out + O_LFP + (size_t)row * 8 : out + O_LFS + (size_t)(row - MP) * 8;
                        *(f32x4*)(dst + fq * 4) = lf;
                    }
            }
            return;
        }
        const int cofs = half + wc * 32 + fq * 4;
        if (type == 0 || type == 3) {
#pragma unroll
            for (int ai = 0; ai < 2; ++ai)
#pragma unroll
                for (int m = 0; m < 4; ++m) {
                    const int row = u.pm * 256 + ai * 128 + wr * 64 + m * 16 + fr;
                    bf16_t* q = Qb + (size_t)row * 1024 + (type == 3 ? 512 : 0) + cofs;
#pragma unroll
                    for (int bj = 0; bj < 2; ++bj)
#pragma unroll
                        for (int n = 0; n < 2; ++n) { const f32x4 v = acc[ai][bj][m][n] * C2; u32x2 w; w.x = pk2(v[0], v[1]); w.y = pk2(v[2], v[3]); *(u32x2*)(q + bj * 128 + n * 16) = w; }
                }
            return;
        }
        const int isv = (type == 2 || type == 5) ? 1 : 0, grp = type >= 3 ? 1 : 0;
#pragma unroll
        for (int ai = 0; ai < 2; ++ai)
#pragma unroll
            for (int m = 0; m < 4; ++m) {
                const int row = u.pm * 256 + ai * 128 + wr * 64 + m * 16 + fr;
                const bool samp = row >= MP; const int s = row - MP;
                float* fo = out + (samp ? O_SBKS + (size_t)(isv + 2 * grp) * KVS_SZ + (size_t)s * 512 : O_SBKP + (size_t)(isv + 2 * grp) * KVP_SZ + (size_t)row * 512) + cofs;
                const size_t brow = samp ? (size_t)s : (size_t)row;
                bf16_t* bo = (bf16_t*)(ws + MiB * (size_t)(100 + 32 * isv + (samp ? 64 + 2 * isv : 0))) + brow * 1024 + grp * 512 + cofs;
#pragma unroll
                for (int bj = 0; bj < 2; ++bj)
#pragma unroll
                    for (int n = 0; n < 2; ++n) { const f32x4 v = acc[ai][bj][m][n]; *(f32x4*)(fo + bj * 128 + n * 16) = v; u32x2 w; w.x = pk2(v[0], v[1]); w.y = pk2(v[2], v[3]); *(u32x2*)(bo + bj * 128 + n * 16) = w; }
            }
    }
};
DI void row_rstd2(const float* ssb, int row, float& r_sb, float& r_fx) {
    const f32x4* sp = (const f32x4*)(ssb + (size_t)row * 16); const f32x4 s0 = sp[0], s1 = sp[1], s2 = sp[2], s3 = sp[3];
    r_sb = 1.0f / sqrtf(((s0[0] + s0[1]) + (s0[2] + s0[3]) + (s1[0] + s1[1]) + (s1[2] + s1[3])) * (1.0f / 512.0f) + EPS);
    r_fx = 1.0f / sqrtf(((s2[0] + s2[1]) + (s2[2] + s2[3]) + (s3[0] + s3[1]) + (s3[2] + s3[3])) * (1.0f / 512.0f) + EPS);
}
template <bool NORM2> struct EpiRes {
    static constexpr bool PERM = false, AFTER_DRAIN = false, MIDK = NORM2; static constexpr int MIDT = 8, MIDPM = 64;
    const float* xp; const float* ada; int gate_off; bf16_t* X1; int mode; float* partA; float* partB; const float* ssb;
    DI void mid(f32x4 (&acc)[2][2][4][2], const pg8::Unit& u, int wr, int wc, int fr, int fq) const {
#pragma unroll
        for (int ai = 0; ai < 2; ++ai)
#pragma unroll
            for (int m = 0; m < 4; ++m) { float r_sb, r_fx; row_rstd2(ssb, u.pm * 256 + ai * 128 + wr * 64 + m * 16 + fr, r_sb, r_fx); const float ratio = r_sb / r_fx;
#pragma unroll
                for (int bj = 0; bj < 2; ++bj)
#pragma unroll
                    for (int n = 0; n < 2; ++n) acc[ai][bj][m][n] *= ratio;
                asm volatile("" ::: "memory"); }
    }
    DI void operator()(const f32x4 (&acc)[2][2][4][2], const pg8::Unit& u, int wr, int wc, int fr, int fq) const {
        const int col0 = u.pn * 256 + wc * 32 + fq * 4;
        if (u.pm >= 64) {
            const int s = u.koff / (u.nt * 64);
            float* pp = (s < 8 ? partA + (size_t)s * 1048576 : partB + (size_t)(s - 8) * 1048576) + col0;
#pragma unroll
            for (int ai = 0; ai < 2; ++ai)
#pragma unroll
                for (int m = 0; m < 4; ++m) {
                    float* po = pp + (size_t)((u.pm - 64) * 256 + ai * 128 + wr * 64 + m * 16 + fr) * 1024;
#pragma unroll
                    for (int bj = 0; bj < 2; ++bj)
#pragma unroll
                        for (int n = 0; n < 2; ++n) *(f32x4*)(po + bj * 128 + n * 16) = acc[ai][bj][m][n];
                }
            return;
        }
#pragma unroll
        for (int ai = 0; ai < 2; ++ai)
#pragma unroll
            for (int m = 0; m < 4; ++m) {
                const int row = u.pm * 256 + ai * 128 + wr * 64 + m * 16 + fr;
                const float* g = ada + (size_t)(row >> 13) * 6144 + gate_off + col0;
                bf16_t* xo = X1 + (size_t)row * 1024 + col0;
                const float* base = xp + (size_t)row * 1024 + col0;
                float rs = 1.0f; if (NORM2) { float r_sb; row_rstd2(ssb, row, r_sb, rs); }
#pragma unroll
                for (int bj = 0; bj < 2; ++bj)
#pragma unroll
                    for (int n = 0; n < 2; ++n) { const f32x4 gv = *(const f32x4*)(g + bj * 128 + n * 16); f32x4 bv;
                        if (mode) { const u32x2 bw = *(const u32x2*)(xo + bj * 128 + n * 16); bv[0] = __uint_as_float(bw.x << 16); bv[1] = __uint_as_float(bw.x & 0xffff0000u); bv[2] = __uint_as_float(bw.y << 16); bv[3] = __uint_as_float(bw.y & 0xffff0000u); }
                        else bv = *(const f32x4*)(base + bj * 128 + n * 16);
                        const f32x4 o = bv + (gv + 1.0f) * (acc[ai][bj][m][n] * rs); u32x2 w; w.x = pk2(o[0], o[1]); w.y = pk2(o[2], o[3]); *(u32x2*)(xo + bj * 128 + n * 16) = w; }
            }
    }
};
struct TailOrder {
    pg8::StaticOrder so; int S, ntk;
    DI void init(int G, int c, int K, int S_) { so.init(MP, 1024, G, c, K); S = S_; ntk = (K / 64) / S_; }
    DI bool next(int i, pg8::Unit& u) const {
        const long L = (long)i * so.G + so.c;
        if (L < so.nwg) return so.next(i, u);
        const int j = (int)(L - so.nwg); if (j >= 16 * S) return false;
        const int su = j / S, sp = j % S;
        u.pm = 64 + (su >> 2); u.pn = su & 3; u.koff = sp * ntk * 64; u.nt = ntk; return true;
    }
    DI void a_ready(const pg8::Unit&) const {}
    DI void done(const pg8::Unit&) const {}
};
struct EpiUp {
    static constexpr bool PERM = false, AFTER_DRAIN = false, MIDK = false;
    bf16_t* H;
    DI void operator()(const f32x4 (&acc)[2][2][4][2], const pg8::Unit& u, int wr, int wc, int fr, int fq) const {
#pragma unroll
        for (int ai = 0; ai < 2; ++ai)
#pragma unroll
            for (int m = 0; m < 4; ++m) {
                const int row = u.pm * 256 + ai * 128 + wr * 64 + m * 16 + fr;
                bf16_t* h = H + (size_t)row * DFF + u.pn * 128 + wc * 32 + fq * 4;
#pragma unroll
                for (int n = 0; n < 2; ++n) { const f32x4 g = acc[ai][0][m][n], up = acc[ai][1][m][n]; f32x4 v;
#pragma unroll
                    for (int e = 0; e < 4; ++e) v[e] = g[e] * __builtin_amdgcn_rcpf(1.0f + ex2(-g[e] * LOG2E)) * up[e];
                    u32x2 w; w.x = pk2(v[0], v[1]); w.y = pk2(v[2], v[3]); *(u32x2*)(h + n * 16) = w; }
            }
    }
};

constexpr int TILE_B = 64 * 144;
#define MFMA32(a, b, c) __builtin_amdgcn_mfma_f32_32x32x16_bf16((a), (b), (c), 0, 0, 0)
DI void attn_unit(LAS unsigned char* lds, const int type, const bf16_t* __restrict__ Q, const bf16_t* __restrict__ K, const bf16_t* __restrict__ V, const float* __restrict__ cK, const float* __restrict__ cV,
                  bf16_t* O, float* ss, const float* fq, const float* fk, const int qpos0, const int nq, const float kmaxn) {
    const int tid = threadIdx.x, lane = tid & 63, wid = __builtin_amdgcn_readfirstlane(tid >> 6), r32 = lane & 31, hi = lane >> 5;
    LAS unsigned char* ldsK = lds; LAS unsigned char* ldsV = lds + 2 * TILE_B; LAS float* fkt = (LAS float*)(lds + 4 * TILE_B); LAS int* flags = (LAS int*)(lds + 4 * TILE_B + 512);
    const bool wactive = wid * 32 < nq;
    const int qrow = wid * 32 + r32, qpos = qpos0 + qrow;
    bf16x8 qr[4];
#pragma unroll
    for (int d0 = 0; d0 < 4; ++d0) { qr[d0] = (bf16x8){0, 0, 0, 0, 0, 0, 0, 0}; if (wactive) qr[d0] = *(const bf16x8*)(Q + (size_t)qrow * 1024 + d0 * 16 + hi * 8); }
    float fq2 = 0.f, qn = 0.f;
    if (type == 1 && wactive) { fq2 = fq[(size_t)qrow * 8] * LOG2E;
#pragma unroll
        for (int d0 = 0; d0 < 4; ++d0)
#pragma unroll
            for (int e = 0; e < 8; ++e) { const float f = bf2f((unsigned short)qr[d0][e]); qn += f * f; }
        qn += __shfl_xor(qn, 32); qn = sqrtf(qn) * kmaxn * 1.0001f; }
    const bool bound = (type == 1) && (kmaxn < 1e30f);
    if (bound) fq2 -= qn;
    f32x16 o0, o1;
#pragma unroll
    for (int r = 0; r < 16; ++r) { o0[r] = 0.f; o1[r] = 0.f; }
    float mrun = -INFINITY, lrun = 0.f, carry = 0.f;
    bool wave_done = !wactive;
    const int kt_hi = (qpos0 + nq - 1) >> 6, wkt = (qpos0 + wid * 32 + 31) >> 6;
    const int krow_l = tid >> 3, kch = tid & 7;
    const int prow = r32;
    const int kst = (krow_l & 32) + (krow_l & 3) + 8 * ((krow_l & 15) >> 2) + 4 * ((krow_l >> 4) & 1);
    u32x4 kregs[2], vregs[2]; float fkregs[2] = {0.f, 0.f};
#define AT_GLOAD(rs_, kt_) do { u32x4 kreg, vreg; float fkreg = 0.f; if (cK != nullptr && (kt_) < 16) { \
            const float* kp_ = cK + (size_t)((kt_) * 64 + krow_l) * 512 + kch * 8; const float* vp_ = cV + (size_t)((kt_) * 64 + lane) * 512 + wid * 8; \
            const f32x4 a0_ = *(const f32x4*)kp_, a1_ = *(const f32x4*)(kp_ + 4), b0_ = *(const f32x4*)vp_, b1_ = *(const f32x4*)(vp_ + 4); \
            kreg.x = pk2(a0_[0], a0_[1]); kreg.y = pk2(a0_[2], a0_[3]); kreg.z = pk2(a1_[0], a1_[1]); kreg.w = pk2(a1_[2], a1_[3]); \
            vreg.x = pk2(b0_[0], b0_[1]); vreg.y = pk2(b0_[2], b0_[3]); vreg.z = pk2(b1_[0], b1_[1]); vreg.w = pk2(b1_[2], b1_[3]); \
        } else { const int kr_ = (cK != nullptr) ? 0 : (kt_) * 64; \
            kreg = *(const u32x4*)(K + (size_t)(kr_ + krow_l) * 1024 + kch * 8); vreg = *(const u32x4*)(V + (size_t)(kr_ + lane) * 1024 + wid * 8); } \
        if (type == 1 && tid < 64) fkreg = fk[(size_t)((kt_) * 64 + tid) * 8] * LOG2E; \
        kregs[rs_] = kreg; vregs[rs_] = vreg; fkregs[rs_] = fkreg; } while (0)
#define AT_LSTORE(rs_, buf_) do { const u32x4 kreg = kregs[rs_], vreg = vregs[rs_]; const float fkreg = fkregs[rs_]; *(LAS u32x4*)(ldsK + (buf_) * TILE_B + kst * 144 + kch * 16) = kreg; \
        LAS unsigned short* vd_ = (LAS unsigned short*)(ldsV + (buf_) * TILE_B + (wid * 8) * 144 + lane * 2); \
        vd_[0] = (unsigned short)(vreg.x & 0xffffu); vd_[72] = (unsigned short)(vreg.x >> 16); vd_[144] = (unsigned short)(vreg.y & 0xffffu); vd_[216] = (unsigned short)(vreg.y >> 16); \
        vd_[288] = (unsigned short)(vreg.z & 0xffffu); vd_[360] = (unsigned short)(vreg.z >> 16); vd_[432] = (unsigned short)(vreg.w & 0xffffu); vd_[504] = (unsigned short)(vreg.w >> 16); \
        if (type == 1 && tid < 64) fkt[(buf_) * 64 + tid] = fkreg; } while (0)
    AT_GLOAD(0, kt_hi); AT_LSTORE(0, 0); __syncthreads();
    if (kt_hi >= 1) AT_GLOAD(1, kt_hi - 1);
    int kt = kt_hi;
    for (;;) {
#pragma unroll
      for (int buf = 0; buf < 2; ++buf) {
        if (kt >= 2) AT_GLOAD(buf, kt - 2);
        if (!wave_done && kt <= wkt) {
            const LAS unsigned char* Kb = ldsK + buf * TILE_B; const LAS unsigned char* Vb = ldsV + buf * TILE_B;
            f32x16 s0, s1;
            { const float ci = type == 1 ? fq2 : 0.f;
#pragma unroll
                for (int r = 0; r < 16; ++r) { s0[r] = ci; s1[r] = ci; } }
            {   bf16x8 ka[4], kb[4];
#pragma unroll
                for (int d0 = 0; d0 < 4; ++d0) { ka[d0] = *(const LAS bf16x8*)(Kb + prow * 144 + (d0 * 16 + hi * 8) * 2); kb[d0] = *(const LAS bf16x8*)(Kb + (32 + prow) * 144 + (d0 * 16 + hi * 8) * 2); }
                __builtin_amdgcn_s_setprio(1);
#pragma unroll
                for (int d0 = 0; d0 < 4; ++d0) { s0 = MFMA32(ka[d0], qr[d0], s0); s1 = MFMA32(kb[d0], qr[d0], s1); }
                __builtin_amdgcn_s_setprio(0);
            }
            const int kvb = kt * 64 + 16 * hi;
            if (type == 1) {
                const LAS f32x4* fk4 = (const LAS f32x4*)(fkt + buf * 64 + 16 * hi);
#pragma unroll
                for (int g = 0; g < 4; ++g) { const f32x4 a = fk4[g], b = fk4[8 + g];
#pragma unroll
                    for (int e = 0; e < 4; ++e) { s0[4 * g + e] -= a[e]; s1[4 * g + e] -= b[e]; } }
                if (kt * 64 + 63 > qpos0 + wid * 32) {
#pragma unroll
                    for (int r = 0; r < 16; ++r) { if (kvb + r > qpos) s0[r] = -INFINITY; if (kvb + 32 + r > qpos) s1[r] = -INFINITY; }
                }
                if (bound) {
                    if (kt == wkt) { float mx = __builtin_fmaxf(s0[0], s1[0]);
#pragma unroll
                        for (int r = 1; r < 16; ++r) mx = __builtin_fmaxf(mx, __builtin_fmaxf(s0[r], s1[r]));
                        mrun = __builtin_fmaxf(mx, __shfl_xor(mx, 32)); }
                    float ps = 0.f;
#pragma unroll
                    for (int r = 0; r < 16; ++r) { s0[r] = ex2(s0[r]); s1[r] = ex2(s1[r]); ps += s0[r] + s1[r]; }
                    lrun += ps;
                } else {
                    float mx = __builtin_fmaxf(s0[0], s1[0]);
#pragma unroll
                    for (int r = 1; r < 16; ++r) mx = __builtin_fmaxf(mx, __builtin_fmaxf(s0[r], s1[r]));
                    mx = __builtin_fmaxf(mx, __shfl_xor(mx, 32));
                    const float mnew = __builtin_fmaxf(mrun, mx), alpha = ex2(mrun - mnew); mrun = mnew;
                    float ps = 0.f;
#pragma unroll
                    for (int r = 0; r < 16; ++r) { s0[r] = ex2(s0[r] - mnew); s1[r] = ex2(s1[r] - mnew); ps += s0[r] + s1[r]; }
                    lrun = lrun * alpha + ps;
                    if (__any(alpha != 1.0f)) {
#pragma unroll
                        for (int r = 0; r < 16; ++r) { o0[r] *= alpha; o1[r] *= alpha; } }
                }
            } else {
                f32x16 l0, l1; float T0 = 0.f, T1 = 0.f;
#pragma unroll
                for (int r = 0; r < 16; ++r) {
                    const float t0 = s0[r], t1 = s1[r];
                    float k0 = -(fmaxf(t0, 0.f) + lg2(1.0f + ex2(-fabsf(t0)))), k1 = -(fmaxf(t1, 0.f) + lg2(1.0f + ex2(-fabsf(t1))));
                    if (!(kvb + r < qpos)) k0 = 0.f;
                    if (!(kvb + 32 + r < qpos)) k1 = 0.f;
                    l0[r] = k0; l1[r] = k1; T0 += k0; T1 += k1;
                }
                const float U0 = __shfl_xor(T0, 32), U1 = __shfl_xor(T1, 32);
                float run = carry + (hi ? 0.f : U1);
#pragma unroll
                for (int r = 15; r >= 0; --r) { run += l1[r]; float a = ex2(s1[r] + run); if (!(kvb + 32 + r < qpos)) a = 0.f; s1[r] = a; }
                run = carry + (hi ? (T1 + U1) : (U1 + T1 + U0));
#pragma unroll
                for (int r = 15; r >= 0; --r) { run += l0[r]; float a = ex2(s0[r] + run); if (!(kvb + r < qpos)) a = 0.f; s0[r] = a; }
                carry += (T0 + T1) + (U0 + U1);
            }
#pragma unroll
            for (int c = 0; c < 4; ++c) {
                u32x4 pw;
                if (c == 0)      { pw.x = pk2(s0[0], s0[1]); pw.y = pk2(s0[2], s0[3]); pw.z = pk2(s0[4], s0[5]); pw.w = pk2(s0[6], s0[7]); }
                else if (c == 1) { pw.x = pk2(s0[8], s0[9]); pw.y = pk2(s0[10], s0[11]); pw.z = pk2(s0[12], s0[13]); pw.w = pk2(s0[14], s0[15]); }
                else if (c == 2) { pw.x = pk2(s1[0], s1[1]); pw.y = pk2(s1[2], s1[3]); pw.z = pk2(s1[4], s1[5]); pw.w = pk2(s1[6], s1[7]); }
                else             { pw.x = pk2(s1[8], s1[9]); pw.y = pk2(s1[10], s1[11]); pw.z = pk2(s1[12], s1[13]); pw.w = pk2(s1[14], s1[15]); }
                const bf16x8 pf = __builtin_bit_cast(bf16x8, pw);
                const int kvoff = 32 * (c >> 1) + 16 * hi + 8 * (c & 1);
                const bf16x8 va = *(const LAS bf16x8*)(Vb + r32 * 144 + kvoff * 2);
                const bf16x8 vb = *(const LAS bf16x8*)(Vb + (32 + r32) * 144 + kvoff * 2);
                o0 = MFMA32(va, pf, o0); o1 = MFMA32(vb, pf, o1);
            }
            if (type == 0) wave_done = __all(carry < -40.0f);
            else wave_done = __all((bound ? 0.f : qn) + fq2 - fkt[buf * 64] - mrun < -40.0f);
        }
        if (lane == 0) flags[buf * 8 + wid] = wave_done ? 1 : 0;
        if (kt >= 1) AT_LSTORE(buf ^ 1, buf ^ 1);
        __syncthreads();
        { int alld = 1;
#pragma unroll
            for (int w = 0; w < 8; ++w) alld &= flags[buf * 8 + w];
            if (alld) goto at_done; }
        if (--kt < 0) goto at_done;
      }
    }
at_done:
#undef AT_GLOAD
#undef AT_LSTORE
    if (wactive) {
        if (type == 1) { const float lt = lrun + __shfl_xor(lrun, 32); const float inv = 1.0f / lt;
#pragma unroll
            for (int r = 0; r < 16; ++r) { o0[r] *= inv; o1[r] *= inv; } }
        float sq = 0.f;
#pragma unroll
        for (int r = 0; r < 16; ++r) sq += o0[r] * o0[r] + o1[r] * o1[r];
        sq += __shfl_xor(sq, 32);
        if (hi == 0) ss[(size_t)qrow * 16] = sq;
        bf16_t* orow = O + (size_t)qrow * 1024 + 4 * hi;
#pragma unroll
        for (int g = 0; g < 4; ++g) {
            u32x2 w0, w1; w0.x = pk2(o0[4 * g], o0[4 * g + 1]); w0.y = pk2(o0[4 * g + 2], o0[4 * g + 3]); w1.x = pk2(o1[4 * g], o1[4 * g + 1]); w1.y = pk2(o1[4 * g + 2], o1[4 * g + 3]);
            *(u32x2*)(orow + 8 * g) = w0; *(u32x2*)(orow + 32 + 8 * g) = w1;
        }
    }
}

DI void transpose_item(const float* W, int K, int N, bf16_t* WT, int dst_row, int k0, int n0, LAS float* scr, int lane, const float* gk = nullptr, bool has_g = false) {
    float tv[32];
#pragma unroll
    for (int i = 0; i < 32; ++i) tv[i] = W[(size_t)(k0 + 2 * i + (lane >> 5)) * N + n0 + (lane & 31)];
    if (has_g) {
#pragma unroll
        for (int i = 0; i < 32; ++i) tv[i] *= gk[2 * i + (lane >> 5)]; }
#pragma unroll
    for (int i = 0; i < 32; ++i) scr[(2 * i + (lane >> 5)) * 33 + (lane & 31)] = tv[i];
    asm volatile("s_waitcnt lgkmcnt(0)" ::: "memory");
    const int c = lane & 7;
#pragma unroll
    for (int j = 0; j < 4; ++j) { const int n = (lane >> 3) + 8 * j; const LAS float* s = scr + (8 * c) * 33 + n;
        u32x4 o; o.x = pk2(s[0 * 33], s[1 * 33]); o.y = pk2(s[2 * 33], s[3 * 33]); o.z = pk2(s[4 * 33], s[5 * 33]); o.w = pk2(s[6 * 33], s[7 * 33]);
        *(u32x4*)(WT + (size_t)(dst_row + n) * K + k0 + 8 * c) = o; }
    asm volatile("s_waitcnt lgkmcnt(0)" ::: "memory");
}
DI void load_row(f32x4 (&v)[4], const float* x, int lane) {
    const f32x4* xr = (const f32x4*)x + lane;
#pragma unroll
    for (int j = 0; j < 4; ++j) v[j] = xr[64 * j];
}
DI void load_row_bf16(f32x4 (&v)[4], const bf16_t* x, int lane) {
#pragma unroll
    for (int j = 0; j < 4; ++j) { const u32x2 w = *(const u32x2*)(x + 4 * lane + 256 * j); v[j][0] = __uint_as_float(w.x << 16); v[j][1] = __uint_as_float(w.x & 0xffff0000u); v[j][2] = __uint_as_float(w.y << 16); v[j][3] = __uint_as_float(w.y & 0xffff0000u); }
}
DI void load_raw_bf16(u32x2 (&w)[4], const bf16_t* x, int lane) {
#pragma unroll
    for (int j = 0; j < 4; ++j) w[j] = *(const u32x2*)(x + 4 * lane + 256 * j);
}
DI void cvt_raw_bf16(f32x4 (&v)[4], const u32x2 (&w)[4]) {
#pragma unroll
    for (int j = 0; j < 4; ++j) { v[j][0] = __uint_as_float(w[j].x << 16); v[j][1] = __uint_as_float(w[j].x & 0xffff0000u); v[j][2] = __uint_as_float(w[j].y << 16); v[j][3] = __uint_as_float(w[j].y & 0xffff0000u); }
}
DI void add_parts(f32x4 (&v)[4], const float* pA, const float* pB, int S, int srow, const float* gate, int lane) {
#pragma unroll
    for (int j = 0; j < 4; ++j) { const int c = 4 * lane + 256 * j; f32x4 sum = {0.f, 0.f, 0.f, 0.f};
        for (int sp = 0; sp < S; ++sp) sum += *(const f32x4*)((sp < 8 ? pA + (size_t)sp * 1048576 : pB + (size_t)(sp - 8) * 1048576) + (size_t)srow * 1024 + c);
        v[j] += (*(const f32x4*)(gate + c) + 1.0f) * sum; }
}
DI void add_parts6(f32x4 (&v)[4], const float* pA, int srow, const float* gate, float r_sb, float r_fx, int lane) {
#pragma unroll
    for (int j = 0; j < 4; ++j) { const int c = 4 * lane + 256 * j; f32x4 sa = {0.f, 0.f, 0.f, 0.f}, sb = {0.f, 0.f, 0.f, 0.f};
#pragma unroll
        for (int sp = 0; sp < 4; ++sp) { sa += *(const f32x4*)(pA + (size_t)sp * 1048576 + (size_t)srow * 1024 + c); sb += *(const f32x4*)(pA + (size_t)(sp + 4) * 1048576 + (size_t)srow * 1024 + c); }
        v[j] += (*(const f32x4*)(gate + c) + 1.0f) * (sa * r_sb + sb * r_fx); }
}
DI float row_rstd(const f32x4 (&v)[4]) {
    float s = 0.f;
#pragma unroll
    for (int j = 0; j < 4; ++j) s += (v[j][0] * v[j][0] + v[j][1] * v[j][1]) + (v[j][2] * v[j][2] + v[j][3] * v[j][3]);
    return 1.0f / sqrtf(wave_sum(s) * (1.0f / 1024.0f) + EPS);
}
DI void norm_store_bf16(const f32x4 (&v)[4], const float* g, const float* scale, const float* shift, bf16_t* o, int lane) {
    const float rstd = row_rstd(v);
#pragma unroll
    for (int j = 0; j < 4; ++j) { const int c = 4 * lane + 256 * j; const f32x4 gv = *(const f32x4*)(g + c), sc = *(const f32x4*)(scale + c), sh = *(const f32x4*)(shift + c);
        const f32x4 r = (v[j] * rstd * gv) * (sc + 1.0f) + sh; u32x2 w; w.x = pk2(r[0], r[1]); w.y = pk2(r[2], r[3]); *(u32x2*)(o + c) = w; }
}
DI void norm_store_f32(const f32x4 (&v)[4], const float* g, float* o, int lane) {
    const float rstd = row_rstd(v);
#pragma unroll
    for (int j = 0; j < 4; ++j) { const int c = 4 * lane + 256 * j; const f32x4 gv = *(const f32x4*)(g + c); *(f32x4*)(o + c) = v[j] * rstd * gv; }
}

struct Args { const float* in[22]; float* out; unsigned char* ws; int ph_lo, ph_hi; };
enum { I_XP = 0, I_XS, I_CP, I_CS, I_CSBK, I_CSBV, I_CFXK, I_CFXV, I_CLF, I_WADA, I_BADA, I_GMIX, I_WIN, I_BF, I_GSB, I_GFX, I_WO, I_GFFN, I_WG, I_WU, I_WD, I_GFIN };
constexpr int NPHASE = 11;

__global__ void __launch_bounds__(512, 2) mk_fwd(Args a) {
    extern __shared__ __attribute__((aligned(16))) unsigned char lds_raw[];
    LAS unsigned char* lds = (LAS unsigned char*)lds_raw;
    cg::grid_group grid = cg::this_grid();
    const int tid = threadIdx.x, lane = tid & 63, wave = __builtin_amdgcn_readfirstlane(tid >> 6);
    const int G = gridDim.x, bid = blockIdx.x;
    const int gw = bid * 8 + wave, NGW = G * 8;
    unsigned char* ws = a.ws; float* out = a.out;
    float* ada = (float*)(ws + WS_ADA); float* fcp = (float*)(ws + WS_FCP); float* fcs = (float*)(ws + WS_FCS); float* ssb = (float*)(ws + WS_SS);
    bf16_t* WinT = (bf16_t*)(ws + WS_WIN); bf16_t* WoT = (bf16_t*)(ws + WS_WO); bf16_t* WguT = (bf16_t*)(ws + WS_WGU); bf16_t* WdT = (bf16_t*)(ws + WS_WD);
    bf16_t* Hn = (bf16_t*)(ws + WS_HN); bf16_t* Qb = (bf16_t*)(ws + WS_QB); bf16_t* Kp = (bf16_t*)(ws + WS_KP); bf16_t* Vp = (bf16_t*)(ws + WS_VP);
    bf16_t* Ks = (bf16_t*)(ws + WS_KS); bf16_t* Vs = (bf16_t*)(ws + WS_VS); bf16_t* Hff = (bf16_t*)(ws + WS_HFF); bf16_t* X1 = (bf16_t*)(ws + WS_X1);
    unsigned* kmax2 = (unsigned*)(ws + WS_KMAX); unsigned* uctr = (unsigned*)(ws + WS_CTR);
    float* part6 = (float*)(ws + 100 * MiB);
    float* part9a = (float*)(ws + WS_HN); float* part9b = (float*)(ws + 160 * MiB);
    const int lo = a.ph_lo, hi_ph = a.ph_hi;
#define IN(k) (lo <= (k) && (k) < hi_ph)
#ifndef REP_SYNC
#define REP_SYNC 1
#endif
#define SEAM(k) do { if (IN(k) && IN((k) + 1)) { for (int rs_ = 0; rs_ < REP_SYNC; ++rs_) xcd_barrier(xbar); } } while (0)
    LAS unsigned* misc = (LAS unsigned*)(lds + 131072);
    if (tid < 16) misc[tid] = 0u;
    __syncthreads();
    XcdBarrier xbar = xcd_barrier_post((unsigned*)(ws + WS_BAR), (volatile LAS unsigned*)(misc + 8));
    if (lo < 0) grid.sync();

    if (IN(0)) {
        for (int cb = bid; cb < 192; cb += G) {
            LAS float* sil = (LAS float*)lds;
            LAS float* red = (LAS float*)(lds + 73728);
            for (int i = tid; i < 18 * 1024; i += 512) { const int b = i >> 10, k = i & 1023; const float c = b < 2 ? a.in[I_CP][b * 1024 + k] : a.in[I_CS][(b - 2) * 1024 + k]; sil[i] = c / (1.0f + expf(-c)); }
            __syncthreads();
            const int kg = tid >> 3, c4 = tid & 7, col0 = cb * 32;
            f32x4 acc[18];
#pragma unroll
            for (int b = 0; b < 18; ++b) acc[b] = (f32x4){0.f, 0.f, 0.f, 0.f};
            const float* wp = a.in[I_WADA] + (size_t)kg * 6144 + col0 + 4 * c4;
#pragma unroll 2
            for (int i = 0; i < 16; ++i) { const f32x4 w4 = *(const f32x4*)(wp + (size_t)i * 64 * 6144); const int k = kg + 64 * i;
#pragma unroll
                for (int b = 0; b < 18; ++b) acc[b] += w4 * sil[b * 1024 + k]; }
#pragma unroll
            for (int b = 0; b < 18; ++b)
#pragma unroll
                for (int e = 0; e < 4; ++e) { float v = acc[b][e]; v += __shfl_xor(v, 8); v += __shfl_xor(v, 16); v += __shfl_xor(v, 32); acc[b][e] = v; }
            if (lane < 8) {
#pragma unroll
                for (int b = 0; b < 18; ++b) *(LAS f32x4*)(red + ((wave * 8 + lane) * 18 + b) * 4) = acc[b]; }
            __syncthreads();
            for (int o = tid; o < 18 * 32; o += 512) { const int b = o >> 5, c = o & 31; float sum = a.in[I_BADA][col0 + c];
#pragma unroll
                for (int w = 0; w < 8; ++w) sum += red[((w * 8 + (c >> 2)) * 18 + b) * 4 + (c & 3)];
                ada[(size_t)b * 6144 + col0 + c] = sum; }
            __syncthreads();
        }
        {
            LAS float* scr = (LAS float*)(lds + 8192 + wave * 8448);
            for (int it = gw; it < 16 * 96; it += NGW) { const int kb = it / 96, nb = it % 96; transpose_item(a.in[I_WIN], 1024, NIN, WinT, nb * 32, kb * 64, nb * 32, scr, lane); }
            for (int i = bid * 512 + tid; i < 8 * 1024; i += G * 512) { const int j = i >> 10, k = i & 1023; const float w = a.in[I_WIN][(size_t)k * NIN + 3072 + j];
                WinT[(size_t)(3072 + j) * 1024 + k] = (bf16_t)(pk2(w, 0.f) & 0xffffu); }
        }
    }
    SEAM(0);
    if (IN(1)) {
        int ln = lane; asm volatile("" : "+v"(ln));
        {
            f32x4 S0[4], S1[4], S2[4], S3[4]; int r = gw;
#define P1_LD(S, k) load_row(S, a.in[I_XP] + (size_t)min(r + (k) * NGW, MP - 1) * 1024, ln)
#define P1_DO(S, k) do { const int row = min(r + (k) * NGW, MP - 1); const float* ad = ada + (size_t)(row >> 13) * 6144; norm_store_bf16(S, a.in[I_GMIX], ad + 1024, ad, Hn + (size_t)row * 1024, ln); } while (0)
            P1_LD(S0, 0); P1_LD(S1, 1); P1_LD(S2, 2); P1_LD(S3, 3);
            for (; r < MP; r += 4 * NGW) { P1_DO(S0, 0); P1_LD(S0, 4); P1_DO(S1, 1); P1_LD(S1, 5); P1_DO(S2, 2); P1_LD(S2, 6); P1_DO(S3, 3); P1_LD(S3, 7); }
#undef P1_LD
#undef P1_DO
        }
        for (int row = MP + gw; row < M; row += NGW) { const float* ad = ada + (size_t)row_batch(row) * 6144;
            f32x4 v[4]; load_row(v, a.in[I_XS] + (size_t)(row - MP) * 1024, ln); norm_store_bf16(v, a.in[I_GMIX], ad + 1024, ad, Hn + (size_t)row * 1024, ln); }
    }
    SEAM(1);
    if (IN(2)) {
        pg8::Gemm g{Hn, WinT, M, NINP, 1024}; pg8::StaticOrder S; S.init(M, NINP, G, bid, 1024);
        EpiIn E{out, Qb, ws, a.in[I_BF]};
        pg8::gemm_phase<EpiIn, pg8::StaticOrder, true, true>(lds, g, S, E);
        {
            const int rem = S.nwg % G, nidle = rem ? G - rem : G, iw = rem ? bid - rem : bid;
            if (iw >= 0) {
                __syncthreads();
                LAS float* scr = (LAS float*)(lds + wave * 8448);
                constexpr int I_O = 16 * 32, I_G = 16 * 88, I_D = 44 * 32, NIT = I_O + 2 * I_G + I_D;
                for (int it = iw * 8 + wave; it < NIT; it += nidle * 8) {
                    int r = it;
                    if (r < I_O) { const int kb = r / 32, nb = r % 32; transpose_item(a.in[I_WO], 1024, 1024, WoT, nb * 32, kb * 64, nb * 32, scr, lane, kb < 8 ? a.in[I_GSB] + kb * 64 : a.in[I_GFX] + (kb - 8) * 64, true); continue; } r -= I_O;
                    if (r < I_G) { const int kb = r / 88, nb = r % 88, n0 = nb * 32; transpose_item(a.in[I_WG], 1024, DFF, WguT, 256 * (n0 >> 7) + (n0 & 127), kb * 64, n0, scr, lane); continue; } r -= I_G;
                    if (r < I_G) { const int kb = r / 88, nb = r % 88, n0 = nb * 32; transpose_item(a.in[I_WU], 1024, DFF, WguT, 256 * (n0 >> 7) + 128 + (n0 & 127), kb * 64, n0, scr, lane); continue; } r -= I_G;
                    { const int kb = r / 32, nb = r % 32; transpose_item(a.in[I_WD], DFF, 1024, WdT, nb * 32, kb * 64, nb * 32, scr, lane); }
                }
            }
        }
    }
    SEAM(2);
    if (IN(3)) {
        LAS float* sm = (LAS float*)lds; LAS float* sm2 = sm + 128;
        for (int job = bid; job < 144 + 256; job += G) {
            if (job < 144) {
                const bool pr = job < 64; int b, c; if (pr) { b = job >> 5; c = job & 31; } else { const int j = job - 64; b = j / 5; c = j - 5 * b; }
                const float* srcA = pr ? out + O_LFP + (size_t)b * TP * 8 : a.in[I_CLF] + (size_t)b * 1024 * 8;
                f32x4 ps = {0.f, 0.f, 0.f, 0.f};
                const f32x4* s4 = (const f32x4*)srcA;
                for (int i0 = 0; i0 < c; i0 += 8) {
                    f32x4 t[8];
#pragma unroll
                    for (int j = 0; j < 8; ++j) { t[j] = (f32x4){0.f, 0.f, 0.f, 0.f}; if (i0 + j < c) t[j] = s4[tid + 512 * (i0 + j)]; }
                    ps += ((t[0] + t[1]) + (t[2] + t[3])) + ((t[4] + t[5]) + (t[6] + t[7])); }
#pragma unroll
                for (int off = 2; off < 64; off <<= 1) { ps[0] += __shfl_xor(ps[0], off); ps[1] += __shfl_xor(ps[1], off); ps[2] += __shfl_xor(ps[2], off); ps[3] += __shfl_xor(ps[3], off); }
                if (lane < 2) *(LAS f32x4*)(sm + (wave * 2 + lane) * 4) = ps;
                const int nrows = (pr || c < 4) ? 256 : 64;
                float v[8];
#pragma unroll
                for (int e = 0; e < 8; ++e) v[e] = 0.f;
                if (tid < nrows) { const float* rp = (pr || c < 4) ? srcA + (size_t)(256 * c + tid) * 8 : out + O_LFS + ((size_t)b * 64 + tid) * 8;
                    const f32x4 v0 = *(const f32x4*)rp, v1 = *(const f32x4*)(rp + 4); v[0] = v0[0]; v[1] = v0[1]; v[2] = v0[2]; v[3] = v0[3]; v[4] = v1[0]; v[5] = v1[1]; v[6] = v1[2]; v[7] = v1[3]; }
#pragma unroll
                for (int off = 1; off < 64; off <<= 1) {
#pragma unroll
                    for (int e = 0; e < 8; ++e) { const float n = __shfl_up(v[e], off); if (lane >= off) v[e] += n; } }
                if (lane == 63) {
#pragma unroll
                    for (int e = 0; e < 8; ++e) sm2[wave * 8 + e] = v[e]; }
                __syncthreads();
#pragma unroll
                for (int e = 0; e < 8; ++e) { float p = 0.f;
#pragma unroll
                    for (int w = 0; w < 8; ++w) p += sm[(w * 2 + (e >> 2)) * 4 + (e & 3)];
                    for (int w = 0; w < wave; ++w) p += sm2[w * 8 + e];
                    v[e] += p; }
                if (tid < nrows) { float* dp = (pr ? fcp + ((size_t)b * TP + 256 * c + tid) * 8 : fcs + ((size_t)b * TS + 256 * c + tid) * 8);
                    *(f32x4*)dp = (f32x4){v[0], v[1], v[2], v[3]}; *(f32x4*)(dp + 4) = (f32x4){v[4], v[5], v[6], v[7]}; }
                __syncthreads();
            } else {
                const int jb = job - 144, row = jb * 64 + (tid >> 3), h = tid & 7;
                const u32x4* kp = (const u32x4*)(Kp + (size_t)row * 1024 + 512 + h * 64);
                float sq = 0.f;
#pragma unroll
                for (int i = 0; i < 8; ++i) { const u32x4 w = kp[i];
                    const float f0 = __uint_as_float(w.x << 16), f1 = __uint_as_float(w.x & 0xffff0000u), f2 = __uint_as_float(w.y << 16), f3 = __uint_as_float(w.y & 0xffff0000u);
                    const float f4 = __uint_as_float(w.z << 16), f5 = __uint_as_float(w.z & 0xffff0000u), f6 = __uint_as_float(w.w << 16), f7 = __uint_as_float(w.w & 0xffff0000u);
                    sq += (f0 * f0 + f1 * f1) + (f2 * f2 + f3 * f3) + (f4 * f4 + f5 * f5) + (f6 * f6 + f7 * f7); }
                sq = fmaxf(sq, __shfl_xor(sq, 8)); sq = fmaxf(sq, __shfl_xor(sq, 16)); sq = fmaxf(sq, __shfl_xor(sq, 32));
                if (lane < 8) atomicMax(kmax2 + (row >> 13) * 8 + lane, __float_as_uint(sq));
            }
        }
    }
    SEAM(3);
    if (IN(4)) for (int rep = 0; rep < REP_ATT; ++rep) {
        if (rep) { xcd_barrier(xbar); if (bid == 0 && tid == 0) __hip_atomic_store(uctr, 0u, __ATOMIC_RELAXED, __HIP_MEMORY_SCOPE_AGENT); xcd_barrier(xbar); }
        LAS int* uslot = (LAS int*)(lds + 4 * TILE_B + 1024);
        for (int first = 1;; first = 0) {
            int u = bid;
            if (!first) {
                if (tid == 0) *uslot = (int)atomicAdd(uctr, 1u) + G;
                __syncthreads();
                u = __builtin_amdgcn_readfirstlane(*uslot);
                __syncthreads();
            }
            if (u >= 1280) break;
            int type, b, h, qb = 0; bool samp = false;
            if (u < 512) { type = 1; qb = 31 - (u >> 4); b = (u >> 3) & 1; h = u & 7; }
            else if (u < 640) { const int w = u - 512; samp = true; type = 1; b = w >> 3; h = w & 7; }
            else if (u < 1152) { const int w = u - 640; type = 0; qb = 31 - (w >> 4); b = (w >> 3) & 1; h = w & 7; }
            else { const int w = u - 1152; samp = true; type = 0; b = w >> 3; h = w & 7; }
            const int colo = type * 512 + h * 64;
            const size_t rb = (size_t)b * TP, q0 = samp ? (size_t)MP + (size_t)b * 64 : rb + (size_t)qb * 256, kb = (size_t)b * TS;
            const bf16_t* Kb_ = samp ? Ks + (size_t)b * 64 * 1024 + colo : Kp + rb * 1024 + colo;
            const bf16_t* Vb_ = samp ? Vs + (size_t)b * 64 * 1024 + colo : Vp + rb * 1024 + colo;
            const float* cK = nullptr; const float* cV = nullptr;
            if (samp) { cK = (type ? a.in[I_CFXK] : a.in[I_CSBK]) + (size_t)b * 1024 * 512 + h * 64; cV = (type ? a.in[I_CFXV] : a.in[I_CSBV]) + (size_t)b * 1024 * 512 + h * 64; }
            const float kmn = (!samp && type == 1) ? sqrtf(__uint_as_float(kmax2[b * 8 + h])) : INFINITY;
            const float* fqp = samp ? fcs + (kb + 1024) * 8 + h : fcp + q0 * 8 + h; const float* fkp = samp ? fcs + kb * 8 + h : fcp + rb * 8 + h;
            attn_unit(lds, type, Qb + q0 * 1024 + colo, Kb_, Vb_, cK, cV, Hn + q0 * 1024 + colo, ssb + q0 * 16 + type * 8 + h, fqp, fkp, samp ? 1024 : qb * 256, samp ? 64 : 256, kmn);
        }
    }
    SEAM(4);
    if (IN(6)) {
        pg8::Gemm g{Hn, WoT, M, 1024, 1024}; TailOrder S; S.init(G, bid, 1024, 8);
        EpiRes<true> E{a.in[I_XP], ada, 2048, X1, 0, part6, part6, ssb};
        pg8::gemm_phase<EpiRes<true>, TailOrder, true, true>(lds, g, S, E);
    }
    SEAM(6);
    if (IN(7)) {
        int ln = lane; asm volatile("" : "+v"(ln));
        {
            u32x2 S0[4], S1[4], S2[4], S3[4]; int r = gw;
#define P7_LD(S, k) load_raw_bf16(S, X1 + (size_t)min(r + (k) * NGW, MP - 1) * 1024, ln)
#define P7_DO(S, k) do { const int row = min(r + (k) * NGW, MP - 1); const float* ad = ada + (size_t)(row >> 13) * 6144; f32x4 v[4]; cvt_raw_bf16(v, S); norm_store_bf16(v, a.in[I_GFFN], ad + 4096, ad + 3072, Hn + (size_t)row * 1024, ln); } while (0)
            P7_LD(S0, 0); P7_LD(S1, 1); P7_LD(S2, 2); P7_LD(S3, 3);
            for (; r < MP; r += 4 * NGW) { P7_DO(S0, 0); P7_LD(S0, 4); P7_DO(S1, 1); P7_LD(S1, 5); P7_DO(S2, 2); P7_LD(S2, 6); P7_DO(S3, 3); P7_LD(S3, 7); }
#undef P7_LD
#undef P7_DO
        }
        for (int row = MP + gw; row < M; row += NGW) { const float* ad = ada + (size_t)row_batch(row) * 6144;
            f32x4 v[4]; load_row(v, a.in[I_XS] + (size_t)(row - MP) * 1024, ln); float r_sb, r_fx; row_rstd2(ssb, row, r_sb, r_fx); add_parts6(v, part6, row - MP, ad + 2048, r_sb, r_fx, ln);
#pragma unroll
            for (int j = 0; j < 4; ++j) { u32x2 w; w.x = pk2(v[j][0], v[j][1]); w.y = pk2(v[j][2], v[j][3]); *(u32x2*)(X1 + (size_t)row * 1024 + 4 * ln + 256 * j) = w; }
            norm_store_bf16(v, a.in[I_GFFN], ad + 4096, ad + 3072, Hn + (size_t)row * 1024, ln); }
    }
    SEAM(7);
    if (IN(8)) {
        pg8::Gemm g{Hn, WguT, M, 2 * DFF, 1024}; pg8::StaticOrder S; S.init(M, 2 * DFF, G, bid, 1024);
        EpiUp E{Hff};
        _Pragma("unroll") for (int rg_ = 0; rg_ < 2; ++rg_) { pg8::gemm_phase<EpiUp, pg8::StaticOrder, true, true>(lds, g, S, E); __syncthreads(); }
    }
    SEAM(8);
    if (IN(9)) {
        pg8::Gemm g{Hff, WdT, M, 1024, DFF}; TailOrder S; S.init(G, bid, DFF, 11);
        EpiRes<false> E{a.in[I_XP], ada, 5120, X1, 1, part9a, part9b, ssb};
        pg8::gemm_phase<EpiRes<false>, TailOrder, true, true>(lds, g, S, E);
    }
    SEAM(9);
    if (IN(10)) {
        int ln = lane; asm volatile("" : "+v"(ln));
        {
            u32x2 S0[4], S1[4], S2[4], S3[4]; int r = gw;
#define P10_LD(S, k) load_raw_bf16(S, X1 + (size_t)min(r + (k) * NGW, MP - 1) * 1024, ln)
#define P10_DO(S, k) do { const int row = min(r + (k) * NGW, MP - 1); f32x4 v[4]; cvt_raw_bf16(v, S); norm_store_f32(v, a.in[I_GFIN], out + O_YP + (size_t)row * 1024, ln); } while (0)
            P10_LD(S0, 0); P10_LD(S1, 1); P10_LD(S2, 2); P10_LD(S3, 3);
            for (; r < MP; r += 4 * NGW) { P10_DO(S0, 0); P10_LD(S0, 4); P10_DO(S1, 1); P10_LD(S1, 5); P10_DO(S2, 2); P10_LD(S2, 6); P10_DO(S3, 3); P10_LD(S3, 7); }
#undef P10_LD
#undef P10_DO
        }
        for (int row = MP + gw; row < M; row += NGW) { f32x4 v[4]; load_row_bf16(v, X1 + (size_t)row * 1024, ln);
            add_parts(v, part9a, part9b, 11, row - MP, ada + (size_t)row_batch(row) * 6144 + 5120, ln);
            norm_store_f32(v, a.in[I_GFIN], out + O_YS + (size_t)(row - MP) * 1024, ln); }
    }
#undef IN
#undef SEAM
}
}

extern "C" void kernel_launch(void* const* d_in, const int* in_sizes, int n_in, void* d_out, int out_size, void* d_ws, size_t ws_size, hipStream_t stream) {
    using namespace mk;
    static int grid = 0;
    if (grid == 0) {
        int dev = 0, cus = 0, per_cu = 0;
        (void)hipGetDevice(&dev); (void)hipDeviceGetAttribute(&cus, hipDeviceAttributeMultiprocessorCount, dev);
        if (hipFuncSetAttribute((const void*)mk_fwd, hipFuncAttributeMaxDynamicSharedMemorySize, LDS_BYTES) != hipSuccess) { fprintf(stderr, "kernel_launch: hipFuncSetAttribute failed\n"); grid = -1; return; }
        if (hipOccupancyMaxActiveBlocksPerMultiprocessor(&per_cu, (const void*)mk_fwd, 512, LDS_BYTES) != hipSuccess || per_cu < 1) { fprintf(stderr, "kernel_launch: occupancy query gave %d\n", per_cu); per_cu = 1; }
        (void)hipGetLastError();
        grid = cus * 1;
        if (grid <= 0) grid = 256;
    }
    if (grid < 0) return;
    (void)hipMemsetAsync((char*)d_ws + WS_BAR, 0, CTL_BYTES - WS_BAR, stream);
    Args a{};
    for (int i = 0; i < 22; ++i) a.in[i] = (const float*)d_in[i];
    a.out = (float*)d_out; a.ws = (unsigned char*)d_ws;
#if MK_MULTI
    for (int p = 0; p < NPHASE; ++p) { a.ph_lo = p; a.ph_hi = p + 1; hipLaunchKernelGGL(mk_fwd, dim3(grid), dim3(512), LDS_BYTES, stream, a); }
#else
    a.ph_lo = 0; a.ph_hi = NPHASE;
    void* args[] = {&a};
    hipError_t e = hipLaunchCooperativeKernel((const void*)mk_fwd, dim3(grid), dim3(512), args, LDS_BYTES, stream);
    if (e != hipSuccess) fprintf(stderr, "cooperative launch failed: %s (grid %d)\n", hipGetErrorString(e), grid);
#endif
}
```

```cpp
#include <hip/hip_runtime.h>
#include <hip/hip_cooperative_groups.h>
#include <cstdio>
#include <cstdint>
namespace cg = cooperative_groups;
namespace pg8 {
#define PG8_LAS __attribute__((address_space(3)))
typedef unsigned short bf16_t;
typedef short bf16x8 __attribute__((ext_vector_type(8)));
typedef float f32x4 __attribute__((ext_vector_type(4)));
typedef unsigned u32x4 __attribute__((ext_vector_type(4)));
constexpr int BM = 256, BK = 64, HALF = 128, HTB = HALF * BK * 2  , STAGE_BYTES = 8 * HTB, NXCD = 8, WGM = 8;

__host__ __device__ __forceinline__ int lds_byte(int r, int c) { const int st = (r >> 4) * 2 + (c >> 5), rr = r & 15, cc = c & 31, ob = rr * 64 + cc * 2; return st * 1024 + (ob ^ (((ob >> 9) & 1) << 5)); }
__host__ __device__ __forceinline__ void stage_rc(int b, int& R, int& C) { const int st = b / 1024, sb = b % 1024, swz = sb ^ (((sb >> 9) & 1) << 5); R = (st >> 1) * 16 + swz / 64; C = (st & 1) * 32 + (swz % 64) / 2; }
__host__ __device__ __forceinline__ int perm32(int rho) { const int n = rho >> 4, i = rho & 15; return 8 * (i >> 2) + 4 * n + (i & 3); }

struct Unit { int pm, pn, koff, nt; };
struct Gemm { const bf16_t* A; const bf16_t* Bt; int M, N, K; };

struct StaticOrder {
    int nM, nN, nwg, G, c, ntf;
    __host__ __device__ __forceinline__ void init(int M, int N, int G_, int c_, int K_) { nM = M / BM; nN = N / BM; nwg = nM * nN; G = G_; c = c_; ntf = K_ / BK; }
    __host__ __device__ __forceinline__ bool next(int i, Unit& u) const {
        const long L = (long)i * G + c; if (L >= nwg) return false;
        int wgid = (int)L; { const int q = nwg / NXCD, r = nwg % NXCD, xcd = wgid % NXCD, off = wgid / NXCD; wgid = (xcd < r ? xcd * (q + 1) : r * (q + 1) + (xcd - r) * q) + off; }
        const int nig = WGM * nN, gid = wgid / nig, fm = gid * WGM, gsz = (nM - fm) < WGM ? (nM - fm) : WGM;
        u.pm = fm + ((wgid % nig) % gsz); u.pn = (wgid % nig) / gsz; u.koff = 0; u.nt = ntf; return true;
    }
    __device__ __forceinline__ void a_ready(const Unit&) const {}
    __device__ __forceinline__ void done(const Unit&) const {}
};

template <class Epi, class Sched, bool ALIGN_EPI = false, bool SP2 = false>
__device__ __forceinline__ void gemm_phase(PG8_LAS unsigned char* lds, const Gemm g, const Sched& S, const Epi& E) {
    const int tid = threadIdx.x, wid = __builtin_amdgcn_readfirstlane(tid >> 6), lane = tid & 63, wr = wid >> 2, wc = wid & 3, fr = lane & 15, fq = lane >> 4;
    const int K = g.K;
    unsigned voffA[2], voffB[2];
#pragma unroll
    for (int i = 0; i < 2; ++i) { int R, C; stage_rc(tid * 16 + i * 8192, R, C); const int Rb = Epi::PERM ? ((R & ~31) + perm32(R & 31)) : R;
        voffA[i] = (unsigned)(R * K + C) * 2u; voffB[i] = (unsigned)(Rb * K + C) * 2u; }
    const size_t kstep = (size_t)(BK * 2);
    const size_t hstep = (size_t)HALF * K * 2;
    const size_t tstep = 2 * hstep;
    const unsigned ldsw = (unsigned)wid * 1024u;
    const int aoff = lds_byte(wr * 64 + fr, fq * 8), boff = lds_byte(wc * 32 + fr, fq * 8);
#define PG8_SA(b, h) (((b) * 2 + (h)) * HTB)
#define PG8_SB(b, h) ((4 + (b) * 2 + (h)) * HTB)
#define PG8_STAGE(bufoff, gbase, voff) do { _Pragma("unroll") for (int _i = 0; _i < 2; ++_i) \
        __builtin_amdgcn_global_load_lds((const unsigned*)((const char*)(gbase) + (voff)[_i]), (PG8_LAS unsigned*)(lds + (bufoff) + ldsw + _i * 8192), 16, 0, 0); } while (0)
#define PG8_LDA(dst, b, h) do { _Pragma("unroll") for (int m = 0; m < 4; ++m) _Pragma("unroll") for (int k = 0; k < 2; ++k) dst[m][k] = *(const PG8_LAS bf16x8*)(lds + PG8_SA(b, h) + aoff + m * 2048 + k * 1024); } while (0)
#define PG8_LDB(dst, b, h) do { _Pragma("unroll") for (int n = 0; n < 2; ++n) _Pragma("unroll") for (int k = 0; k < 2; ++k) dst[n][k] = *(const PG8_LAS bf16x8*)(lds + PG8_SB(b, h) + boff + n * 2048 + k * 1024); } while (0)
#define PG8_MMA(ai, bj, At, Bt) do { __builtin_amdgcn_s_setprio(1); _Pragma("unroll") for (int m = 0; m < 4; ++m) _Pragma("unroll") for (int n = 0; n < 2; ++n) _Pragma("unroll") for (int k = 0; k < 2; ++k) \
        acc[ai][bj][m][n] = __builtin_amdgcn_mfma_f32_16x16x32_bf16(Bt[n][k], At[m][k], acc[ai][bj][m][n], 0, 0, 0); __builtin_amdgcn_s_setprio(0); } while (0)
#define PG8_WAIT_V(n) asm volatile("s_waitcnt vmcnt(" #n ")" ::: "memory")
#define PG8_WAIT_L(n) asm volatile("s_waitcnt lgkmcnt(" #n ")" ::: "memory")
#define PG8_BAR __builtin_amdgcn_s_barrier()
#define PG8_SCHED __builtin_amdgcn_sched_barrier(0)
    Unit cur, nxt; int ui = 0;
    if (!S.next(0, cur)) return;
    f32x4 acc[2][2][4][2];
#pragma unroll
    for (int a = 0; a < 2; ++a)
#pragma unroll
        for (int b = 0; b < 2; ++b)
#pragma unroll
            for (int m = 0; m < 4; ++m)
#pragma unroll
                for (int n = 0; n < 2; ++n) acc[a][b][m][n] = (f32x4){0.f, 0.f, 0.f, 0.f};
    bf16x8 At[4][2], B0[2][2], B1[2][2];
    const char* cA = (const char*)g.A + (size_t)cur.pm * tstep + (size_t)cur.koff * 2; const char* cB = (const char*)g.Bt + (size_t)cur.pn * tstep + (size_t)cur.koff * 2;
    S.a_ready(cur);
    if constexpr (SP2) {
        PG8_STAGE(PG8_SB(0, 0), cB, voffB); PG8_STAGE(PG8_SB(0, 1), cB + hstep, voffB); PG8_STAGE(PG8_SA(0, 0), cA, voffA); PG8_STAGE(PG8_SA(0, 1), cA + hstep, voffA);
        if (wr == 1) PG8_BAR;
        PG8_WAIT_V(2); PG8_BAR;
        PG8_STAGE(PG8_SB(1, 0), cB + kstep, voffB); PG8_STAGE(PG8_SA(1, 0), cA + kstep, voffA); PG8_STAGE(PG8_SB(1, 1), cB + hstep + kstep, voffB);
        PG8_WAIT_V(6); PG8_BAR;
    } else {
        PG8_STAGE(PG8_SB(0, 0), cB, voffB); PG8_STAGE(PG8_SA(0, 0), cA, voffA); PG8_STAGE(PG8_SB(0, 1), cB + hstep, voffB); PG8_STAGE(PG8_SA(0, 1), cA + hstep, voffA);
        if (wr == 1) PG8_BAR;
        PG8_WAIT_V(4); PG8_BAR;
        PG8_STAGE(PG8_SB(1, 0), cB + kstep, voffB); PG8_STAGE(PG8_SA(1, 0), cA + kstep, voffA); PG8_STAGE(PG8_SB(1, 1), cB + hstep + kstep, voffB);
        PG8_WAIT_V(6); PG8_BAR;
    }
    for (;;) {
        const bool has_next = S.next(ui + 1, nxt);
        const char* nA = has_next ? (const char*)g.A + (size_t)nxt.pm * tstep + (size_t)nxt.koff * 2 : cA; const char* nB = has_next ? (const char*)g.Bt + (size_t)nxt.pn * tstep + (size_t)nxt.koff * 2 : cB;
        const int nt = cur.nt;
        for (int t = 0; t < nt; t += 2) {
            const bool last = (t == nt - 2);
            if constexpr (Epi::MIDK) { if (t == Epi::MIDT && cur.pm < Epi::MIDPM) E.mid(acc, cur, wr, wc, fr, fq); }
            const char* a1 = cA + (size_t)(t + 1) * kstep;
            const char* a2 = last ? nA : cA + (size_t)(t + 2) * kstep; const char* b2 = last ? nB : cB + (size_t)(t + 2) * kstep;
            const char* a3 = a2 + kstep; const char* b3 = b2 + kstep;
            if (last && has_next) S.a_ready(nxt);
            if constexpr (SP2) {
            PG8_LDB(B0, 0, 0); PG8_LDB(B1, 0, 1); PG8_SCHED; PG8_LDA(At, 0, 0); PG8_STAGE(PG8_SA(1, 1), a1 + hstep, voffA);
            PG8_WAIT_V(8); PG8_WAIT_L(0); PG8_BAR; PG8_MMA(0, 0, At, B0); PG8_MMA(0, 1, At, B1); PG8_BAR; PG8_SCHED;
            PG8_LDA(At, 0, 1); PG8_STAGE(PG8_SB(0, 0), b2, voffB); PG8_STAGE(PG8_SB(0, 1), b2 + hstep, voffB); PG8_STAGE(PG8_SA(0, 0), a2, voffA);
            PG8_WAIT_V(8); PG8_WAIT_L(0); PG8_BAR; PG8_MMA(1, 0, At, B0); PG8_MMA(1, 1, At, B1); PG8_BAR; PG8_SCHED;
            PG8_LDB(B0, 1, 0); PG8_LDB(B1, 1, 1); PG8_SCHED; PG8_LDA(At, 1, 0); PG8_STAGE(PG8_SA(0, 1), a2 + hstep, voffA);
            PG8_WAIT_V(8); PG8_WAIT_L(0); PG8_BAR; PG8_MMA(0, 0, At, B0); PG8_MMA(0, 1, At, B1); PG8_BAR; PG8_SCHED;
            PG8_LDA(At, 1, 1); PG8_STAGE(PG8_SB(1, 0), b3, voffB); PG8_STAGE(PG8_SB(1, 1), b3 + hstep, voffB); PG8_STAGE(PG8_SA(1, 0), a3, voffA);
            PG8_WAIT_V(8); PG8_WAIT_L(0); PG8_BAR; PG8_MMA(1, 0, At, B0); PG8_MMA(1, 1, At, B1); PG8_BAR; PG8_SCHED;
            } else {
            PG8_LDB(B0, 0, 0); PG8_SCHED; PG8_LDA(At, 0, 0); PG8_STAGE(PG8_SA(1, 1), a1 + hstep, voffA);
            PG8_WAIT_L(8); PG8_BAR; PG8_WAIT_L(0); PG8_MMA(0, 0, At, B0); PG8_BAR; PG8_SCHED;
            PG8_LDB(B1, 0, 1); PG8_STAGE(PG8_SB(0, 0), b2, voffB);
            PG8_BAR; PG8_WAIT_L(0); PG8_MMA(0, 1, At, B1); PG8_BAR;
            PG8_LDA(At, 0, 1); PG8_STAGE(PG8_SA(0, 0), a2, voffA);
            PG8_BAR; PG8_WAIT_L(0); PG8_MMA(1, 0, At, B0); PG8_BAR; PG8_SCHED;
            PG8_STAGE(PG8_SB(0, 1), b2 + hstep, voffB);
            PG8_WAIT_V(6); PG8_BAR; PG8_MMA(1, 1, At, B1); PG8_BAR;
            PG8_LDB(B0, 1, 0); PG8_SCHED; PG8_LDA(At, 1, 0); PG8_STAGE(PG8_SA(0, 1), a2 + hstep, voffA);
            PG8_WAIT_L(8); PG8_BAR; PG8_WAIT_L(0); PG8_MMA(0, 0, At, B0); PG8_BAR; PG8_SCHED;
            PG8_LDB(B1, 1, 1); PG8_STAGE(PG8_SB(1, 0), b3, voffB);
            PG8_BAR; PG8_WAIT_L(0); PG8_MMA(0, 1, At, B1); PG8_BAR;
            PG8_LDA(At, 1, 1); PG8_STAGE(PG8_SA(1, 0), a3, voffA);
            PG8_BAR; PG8_WAIT_L(0); PG8_MMA(1, 0, At, B0); PG8_BAR; PG8_SCHED;
            PG8_STAGE(PG8_SB(1, 1), b3 + hstep, voffB);
            PG8_WAIT_V(6); PG8_BAR; PG8_MMA(1, 1, At, B1); PG8_BAR;
            }
        }
        if constexpr (ALIGN_EPI) { if (wr == 0) PG8_BAR; }
        if constexpr (!Epi::AFTER_DRAIN) { E(acc, cur, wr, wc, fr, fq); S.done(cur); }
        if (!has_next) break;
#pragma unroll
        for (int a = 0; a < 2; ++a)
#pragma unroll
            for (int b = 0; b < 2; ++b)
#pragma unroll
                for (int m = 0; m < 4; ++m)
#pragma unroll
                    for (int n = 0; n < 2; ++n) acc[a][b][m][n] = (f32x4){0.f, 0.f, 0.f, 0.f};
        cur = nxt; cA = nA; cB = nB; ++ui;
        if constexpr (ALIGN_EPI) { if (wr == 1) PG8_BAR; }
    }
    PG8_WAIT_V(0);
    if constexpr (!ALIGN_EPI) { if (wr == 0) PG8_BAR; }
    PG8_BAR;
    if constexpr (Epi::AFTER_DRAIN) { E.fused(acc, cur, wr, wc, fr, fq, lds, wid, lane); S.done(cur); }
#undef PG8_SA
#undef PG8_SB
#undef PG8_STAGE
#undef PG8_LDA
#undef PG8_LDB
#undef PG8_MMA
#undef PG8_WAIT_V
#undef PG8_WAIT_L
#undef PG8_BAR
#undef PG8_SCHED
}
}

#ifndef REP_ATT
#define REP_ATT 1
#endif
#ifndef REP_GEMM
#define REP_GEMM 1
#endif
#ifndef MK_MULTI
#define MK_MULTI 0
#endif
namespace mk {
using pg8::bf16_t; using pg8::bf16x8; using pg8::f32x4; using pg8::u32x4;
typedef float f32x16 __attribute__((ext_vector_type(16)));
typedef unsigned u32x2 __attribute__((ext_vector_type(2)));
#define LAS __attribute__((address_space(3)))
#define DI __device__ __forceinline__

#define XB_TMO      128
#define XB_XCNT(j)  (256  + 64 * (j))
#define XB_XSUB(j)  (1280 + 64 * (j))
#define XB_XGEN(j)  (2304 + 64 * (j))
#define XB_TOP      3328
#define XB_TOPGEN   3392
#define XCD_BAR_WORDS 3456
#define XB_SPIN_CAP (1u << 18)

__device__ __forceinline__ unsigned xb_ld(unsigned* p)              { return __hip_atomic_load(p, __ATOMIC_RELAXED, __HIP_MEMORY_SCOPE_AGENT); }
__device__ __forceinline__ unsigned xb_add(unsigned* p, unsigned v) { return __hip_atomic_fetch_add(p, v, __ATOMIC_RELAXED, __HIP_MEMORY_SCOPE_AGENT); }
__device__ __forceinline__ unsigned xb_xcc_id() { return (unsigned)__builtin_amdgcn_s_getreg((3 << 11) | 20) & 0xFu; }
#define XB_SPIN(cond, bar) do { unsigned _sp = 0; while (cond) { __builtin_amdgcn_s_sleep(1); \
    if ((++_sp & 255u) == 0u) { if (xb_ld(&(bar)[XB_TMO])) break; if (_sp > XB_SPIN_CAP) { atomicAdd(&(bar)[XB_TMO], 1u); break; } } } } while (0)

struct XcdBarrier {
    unsigned* bar; unsigned x;
    volatile LAS unsigned* st;
};

__device__ __forceinline__ XcdBarrier xcd_barrier_post(unsigned* bar, volatile LAS unsigned* st) {
    XcdBarrier b; b.bar = bar; b.x = xb_xcc_id(); b.st = st;
    if (threadIdx.x == 0) (void)xb_add(&bar[XB_XCNT(b.x)], 1u);
    return b;
}
__device__ __forceinline__ void xcd_barrier_complete(unsigned* bar, unsigned x, unsigned& nloc, unsigned& nx) {
    const unsigned G = gridDim.x * gridDim.y * gridDim.z;
    unsigned sum, cnt, mine, sp = 0u;
    for (;;) {
        sum = 0u; cnt = 0u; mine = 0u;
#pragma unroll
        for (unsigned j = 0; j < 16; ++j) { const unsigned c = xb_ld(&bar[XB_XCNT(j)]); sum += c; cnt += (c > 0u) ? 1u : 0u; mine = (j == x) ? c : mine; }
        if (sum == G) break;
        __builtin_amdgcn_s_sleep(1);
        if ((++sp & 255u) == 0u) { if (xb_ld(&bar[XB_TMO])) break; if (sp > XB_SPIN_CAP) { atomicAdd(&bar[XB_TMO], 1u); break; } }
    }
    nloc = mine > 0u ? mine : 1u; nx = cnt > 0u ? cnt : 1u;
}

__device__ __forceinline__ void xcd_barrier(const XcdBarrier& b) {
    asm volatile("s_waitcnt vmcnt(0)" ::: "memory");
    __syncthreads();
    if (threadIdx.x == 0) {
        unsigned* bar = b.bar;
        __builtin_amdgcn_s_waitcnt(0);
        unsigned nloc = b.st[0], nx = b.st[1];
        if (nloc == 0u) { xcd_barrier_complete(bar, b.x, nloc, nx); b.st[0] = nloc; b.st[1] = nx; }
        const unsigned old = xb_add(&bar[XB_XSUB(b.x)], 1u);
        const unsigned gen = old / nloc;
        if (old + 1u == (gen + 1u) * nloc) {
            __builtin_amdgcn_fence(__ATOMIC_RELEASE, "agent");
            asm volatile("s_waitcnt vmcnt(0)" ::: "memory");
            const unsigned og = xb_add(&bar[XB_TOP], 1u);
            const unsigned tg = og / nx;
            if (og + 1u == (tg + 1u) * nx) xb_add(&bar[XB_TOPGEN], 1u);
            else XB_SPIN(xb_ld(&bar[XB_TOPGEN]) == tg, bar);
            __builtin_amdgcn_fence(__ATOMIC_ACQUIRE, "agent");
            xb_add(&bar[XB_XGEN(b.x)], 1u);
            asm volatile("s_waitcnt vmcnt(0)" ::: "memory");
        } else {
            XB_SPIN(xb_ld(&bar[XB_XGEN(b.x)]) == gen, bar);
            __builtin_amdgcn_fence(__ATOMIC_ACQUIRE, "agent");
            asm volatile("s_waitcnt vmcnt(0)" ::: "memory");
        }
    }
    __syncthreads();
}

constexpr int MP = 16384, MS = 1024, M = MP + MS, D = 1024, NIN = 3080, NINP = 3328, DFF = 2816, TS = 1088, TP = 8192;
constexpr float LOG2E = 1.4426950408889634f, C2 = 0.125f * LOG2E, EPS = 1e-6f;
constexpr size_t O_YP = 0, O_YS = 16777216, O_SBKP = 17825792, O_LFP = 51380224, O_SBKS = 51511296, O_LFS = 53608448;
constexpr size_t KVP_SZ = 8388608, KVS_SZ = 524288;
constexpr size_t MiB = 1u << 20;
constexpr size_t WS_ADA = 0, ADA_BYTES = 18 * 6144 * 4, WS_BAR = 512 * 1024, WS_KMAX = WS_BAR + 16384, WS_CTR = WS_KMAX + 256, CTL_BYTES = WS_CTR + 256;
constexpr size_t WS_FCP = 1 * MiB, WS_FCS = 2 * MiB, WS_SS = 3 * MiB;
constexpr size_t WS_WIN = 5 * MiB, WS_WO = 12 * MiB, WS_WGU = 14 * MiB, WS_WD = 25 * MiB;
constexpr size_t WS_HN = 32 * MiB, WS_QB = 66 * MiB, WS_KP = 100 * MiB, WS_VP = 132 * MiB, WS_KS = 164 * MiB, WS_VS = 198 * MiB;
constexpr size_t WS_HFF = 66 * MiB;
constexpr size_t WS_X1 = 188 * MiB;
static_assert(WS_KP == 100 * MiB && WS_VP == 132 * MiB && WS_KS == 164 * MiB && WS_VS == 198 * MiB && WS_HFF + (size_t)M * DFF * 2 <= WS_X1 && WS_X1 + (size_t)M * D * 4 <= 256 * MiB, "ws map");
constexpr int LDS_BYTES = 135168;

DI unsigned pk2(float lo, float hi) { typedef float f2 __attribute__((ext_vector_type(2))); typedef __bf16 b2 __attribute__((ext_vector_type(2))); f2 v = {lo, hi}; b2 b = __builtin_convertvector(v, b2); return __builtin_bit_cast(unsigned, b); }
DI float bf2f(unsigned short b) { return __uint_as_float((unsigned)b << 16); }
DI float ex2(float x) { return __builtin_amdgcn_exp2f(x); }
DI float lg2(float x) { return __builtin_amdgcn_logf(x); }
DI float wave_sum(float v) {
#pragma unroll
    for (int o = 1; o < 64; o <<= 1) v += __shfl_xor(v, o);
    return v;
}
DI int row_batch(int row) { return row < MP ? (row >> 13) : 2 + ((row - MP) >> 6); }
DI float logsig(float x) { return fminf(x, 0.f) - log1pf(expf(-fabsf(x))); }

struct EpiIn {
    static constexpr bool PERM = false, AFTER_DRAIN = false, MIDK = false;
    float* out; bf16_t* Qb; unsigned char* ws; const float* b_f;
    DI void operator()(const f32x4 (&acc)[2][2][4][2], const pg8::Unit& u, int wr, int wc, int fr, int fq) const {
        const int pn = u.pn, type = pn >> 1, half = (pn & 1) * 256;
        if (type == 6) {
            if (wc == 0 && fq < 2) {
                const f32x4 bf = *(const f32x4*)(b_f + fq * 4);
#pragma unroll
                for (int ai = 0; ai < 2; ++ai)
#pragma unroll
                    for (int m = 0; m < 4; ++m) {
                        const int row = u.pm * 256 + ai * 128 + wr * 64 + m * 16 + fr;
                        const f32x4 v = acc[ai][0][m][0] + bf;
                        f32x4 lf; lf[0] = logsig(v[0]); lf[1] = logsig(v[1]); lf[2] = logsig(v[2]); lf[3] = logsig(v[3]);
                        float* dst = row < MP ? out + O_LFP + (size_t)row * 8 : out + O_LFS + (size_t)(row - MP) * 8;
                        *(f32x4*)(dst + fq * 4) = lf;
                    }
            }
            return;
        }
        const int cofs = half + wc * 32 + fq * 4;
        if (type == 0 || type == 3) {
#pragma unroll
            for (int ai = 0; ai < 2; ++ai)
#pragma unroll
                for (int m = 0; m < 4; ++m) {
                    const int row = u.pm * 256 + ai * 128 + wr * 64 + m * 16 + fr;
                    bf16_t* q = Qb + (size_t)row * 1024 + (type == 3 ? 512 : 0) + cofs;
#pragma unroll
                    for (int bj = 0; bj < 2; ++bj)
#pragma unroll
                        for (int n = 0; n < 2; ++n) { const f32x4 v = acc[ai][bj][m][n] * C2; u32x2 w; w.x = pk2(v[0], v[1]); w.y = pk2(v[2], v[3]); *(u32x2*)(q + bj * 128 + n * 16) = w; }
                }
            return;
        }
        const int isv = (type == 2 || type == 5) ? 1 : 0, grp = type >= 3 ? 1 : 0;
#pragma unroll
        for (int ai = 0; ai < 2; ++ai)
#pragma unroll
            for (int m = 0; m < 4; ++m) {
                const int row = u.pm * 256 + ai * 128 + wr * 64 + m * 16 + fr;
                const bool samp = row >= MP; const int s = row - MP;
                float* fo = out + (samp ? O_SBKS + (size_t)(isv + 2 * grp) * KVS_SZ + (size_t)s * 512 : O_SBKP + (size_t)(isv + 2 * grp) * KVP_SZ + (size_t)row * 512) + cofs;
                const size_t brow = samp ? (size_t)s : (size_t)row;
                bf16_t* bo = (bf16_t*)(ws + MiB * (size_t)(100 + 32 * isv + (samp ? 64 + 2 * isv : 0))) + brow * 1024 + grp * 512 + cofs;
#pragma unroll
                for (int bj = 0; bj < 2; ++bj)
#pragma unroll
                    for (int n = 0; n < 2; ++n) { const f32x4 v = acc[ai][bj][m][n]; *(f32x4*)(fo + bj * 128 + n * 16) = v; u32x2 w; w.x = pk2(v[0], v[1]); w.y = pk2(v[2], v[3]); *(u32x2*)(bo + bj * 128 + n * 16) = w; }
            }
    }
};
DI void row_rstd2(const float* ssb, int row, float& r_sb, float& r_fx) {
    const f32x4* sp = (const f32x4*)(ssb + (size_t)row * 16); const f32x4 s0 = sp[0], s1 = sp[1], s2 = sp[2], s3 = sp[3];
    r_sb = 1.0f / sqrtf(((s0[0] + s0[1]) + (s0[2] + s0[3]) + (s1[0] + s1[1]) + (s1[2] + s1[3])) * (1.0f / 512.0f) + EPS);
    r_fx = 1.0f / sqrtf(((s2[0] + s2[1]) + (s2[2] + s2[3]) + (s3[0] + s3[1]) + (s3[2] + s3[3])) * (1.0f / 512.0f) + EPS);
}
template <bool NORM2> struct EpiRes {
    static constexpr bool PERM = false, AFTER_DRAIN = false, MIDK = NORM2; static constexpr int MIDT = 8, MIDPM = 64;
    const float* xp; const float* ada; int gate_off; bf16_t* X1; int mode; float* partA; float* partB; const float* ssb;
    DI void mid(f32x4 (&acc)[2][2][4][2], const pg8::Unit& u, int wr, int wc, int fr, int fq) const {
#pragma unroll
        for (int ai = 0; ai < 2; ++ai)
#pragma unroll
            for (int m = 0; m < 4; ++m) { float r_sb, r_fx; row_rstd2(ssb, u.pm * 256 + ai * 128 + wr * 64 + m * 16 + fr, r_sb, r_fx); const float ratio = r_sb / r_fx;
#pragma unroll
                for (int bj = 0; bj < 2; ++bj)
#pragma unroll
                    for (int n = 0; n < 2; ++n) acc[ai][bj][m][n] *= ratio;
                asm volatile("" ::: "memory"); }
    }
    DI void operator()(const f32x4 (&acc)[2][2][4][2], const pg8::Unit& u, int wr, int wc, int fr, int fq) const {
        const int col0 = u.pn * 256 + wc * 32 + fq * 4;
        if (u.pm >= 64) {
            const int s = u.koff / (u.nt * 64);
            float* pp = (s < 8 ? partA + (size_t)s * 1048576 : partB + (size_t)(s - 8) * 1048576) + col0;
#pragma unroll
            for (int ai = 0; ai < 2; ++ai)
#pragma unroll
                for (int m = 0; m < 4; ++m) {
                    float* po = pp + (size_t)((u.pm - 64) * 256 + ai * 128 + wr * 64 + m * 16 + fr) * 1024;
#pragma unroll
                    for (int bj = 0; bj < 2; ++bj)
#pragma unroll
                        for (int n = 0; n < 2; ++n) *(f32x4*)(po + bj * 128 + n * 16) = acc[ai][bj][m][n];
                }
            return;
        }
#pragma unroll
        for (int ai = 0; ai < 2; ++ai)
#pragma unroll
            for (int m = 0; m < 4; ++m) {
                const int row = u.pm * 256 + ai * 128 + wr * 64 + m * 16 + fr;
                const float* g = ada + (size_t)(row >> 13) * 6144 + gate_off + col0;
                bf16_t* xo = X1 + (size_t)row * 1024 + col0;
                const float* base = xp + (size_t)row * 1024 + col0;
                float rs = 1.0f; if (NORM2) { float r_sb; row_rstd2(ssb, row, r_sb, rs); }
#pragma unroll
                for (int bj = 0; bj < 2; ++bj)
#pragma unroll
                    for (int n = 0; n < 2; ++n) { const f32x4 gv = *(const f32x4*)(g + bj * 128 + n * 16); f32x4 bv;
                        if (mode) { const u32x2 bw = *(const u32x2*)(xo + bj * 128 + n * 16); bv[0] = __uint_as_float(bw.x << 16); bv[1] = __uint_as_float(bw.x & 0xffff0000u); bv[2] = __uint_as_float(bw.y << 16); bv[3] = __uint_as_float(bw.y & 0xffff0000u); }
                        else bv = *(const f32x4*)(base + bj * 128 + n * 16);
                        const f32x4 o = bv + (gv + 1.0f) * (acc[ai][bj][m][n] * rs); u32x2 w; w.x = pk2(o[0], o[1]); w.y = pk2(o[2], o[3]); *(u32x2*)(xo + bj * 128 + n * 16) = w; }
            }
    }
};
struct TailOrder {
    pg8::StaticOrder so; int S, ntk;
    DI void init(int G, int c, int K, int S_) { so.init(MP, 1024, G, c, K); S = S_; ntk = (K / 64) / S_; }
    DI bool next(int i, pg8::Unit& u) const {
        const long L = (long)i * so.G + so.c;
        if (L < so.nwg) return so.next(i, u);
        const int j = (int)(L - so.nwg); if (j >= 16 * S) return false;
        const int su = j / S, sp = j % S;
        u.pm = 64 + (su >> 2); u.pn = su & 3; u.koff = sp * ntk * 64; u.nt = ntk; return true;
    }
    DI void a_ready(const pg8::Unit&) const {}
    DI void done(const pg8::Unit&) const {}
};
struct EpiUp {
    static constexpr bool PERM = false, AFTER_DRAIN = false, MIDK = false;
    bf16_t* H;
    DI void operator()(const f32x4 (&acc)[2][2][4][2], const pg8::Unit& u, int wr, int wc, int fr, int fq) const {
#pragma unroll
        for (int ai = 0; ai < 2; ++ai)
#pragma unroll
            for (int m = 0; m < 4; ++m) {
                const int row = u.pm * 256 + ai * 128 + wr * 64 + m * 16 + fr;
                bf16_t* h = H + (size_t)row * DFF + u.pn * 128 + wc * 32 + fq * 4;
#pragma unroll
                for (int n = 0; n < 2; ++n) { const f32x4 g = acc[ai][0][m][n], up = acc[ai][1][m][n]; f32x4 v;
#pragma unroll
                    for (int e = 0; e < 4; ++e) v[e] = g[e] * __builtin_amdgcn_rcpf(1.0f + ex2(-g[e] * LOG2E)) * up[e];
                    u32x2 w; w.x = pk2(v[0], v[1]); w.y = pk2(v[2], v[3]); *(u32x2*)(h + n * 16) = w; }
            }
    }
};

constexpr int TILE_B = 64 * 144;
#define MFMA32(a, b, c) __builtin_amdgcn_mfma_f32_32x32x16_bf16((a), (b), (c), 0, 0, 0)
DI void attn_unit(LAS unsigned char* lds, const int type, const bf16_t* __restrict__ Q, const bf16_t* __restrict__ K, const bf16_t* __restrict__ V, const float* __restrict__ cK, const float* __restrict__ cV,
                  bf16_t* O, float* ss, const float* fq, const float* fk, const int qpos0, const int nq, const float kmaxn) {
    const int tid = threadIdx.x, lane = tid & 63, wid = __builtin_amdgcn_readfirstlane(tid >> 6), r32 = lane & 31, hi = lane >> 5;
    LAS unsigned char* ldsK = lds; LAS unsigned char* ldsV = lds + 2 * TILE_B; LAS float* fkt = (LAS float*)(lds + 4 * TILE_B); LAS int* flags = (LAS int*)(lds + 4 * TILE_B + 512);
    const bool wactive = wid * 32 < nq;
    const int qrow = wid * 32 + r32, qpos = qpos0 + qrow;
    bf16x8 qr[4];
#pragma unroll
    for (int d0 = 0; d0 < 4; ++d0) { qr[d0] = (bf16x8){0, 0, 0, 0, 0, 0, 0, 0}; if (wactive) qr[d0] = *(const bf16x8*)(Q + (size_t)qrow * 1024 + d0 * 16 + hi * 8); }
    float fq2 = 0.f, qn = 0.f;
    if (type == 1 && wactive) { fq2 = fq[(size_t)qrow * 8] * LOG2E;
#pragma unroll
        for (int d0 = 0; d0 < 4; ++d0)
#pragma unroll
            for (int e = 0; e < 8; ++e) { const float f = bf2f((unsigned short)qr[d0][e]); qn += f * f; }
        qn += __shfl_xor(qn, 32); qn = sqrtf(qn) * kmaxn * 1.0001f; }
    const bool bound = (type == 1) && (kmaxn < 1e30f);
    if (bound) fq2 -= qn;
    f32x16 o0, o1;
#pragma unroll
    for (int r = 0; r < 16; ++r) { o0[r] = 0.f; o1[r] = 0.f; }
    float mrun = -INFINITY, lrun = 0.f, carry = 0.f;
    bool wave_done = !wactive;
    const int kt_hi = (qpos0 + nq - 1) >> 6, wkt = (qpos0 + wid * 32 + 31) >> 6;
    const int krow_l = tid >> 3, kch = tid & 7;
    const int prow = r32;
    const int kst = (krow_l & 32) + (krow_l & 3) + 8 * ((krow_l & 15) >> 2) + 4 * ((krow_l >> 4) & 1);
    u32x4 kregs[2], vregs[2]; float fkregs[2] = {0.f, 0.f};
#define AT_GLOAD(rs_, kt_) do { u32x4 kreg, vreg; float fkreg = 0.f; if (cK != nullptr && (kt_) < 16) { \
            const float* kp_ = cK + (size_t)((kt_) * 64 + krow_l) * 512 + kch * 8; const float* vp_ = cV + (size_t)((kt_) * 64 + lane) * 512 + wid * 8; \
            const f32x4 a0_ = *(const f32x4*)kp_, a1_ = *(const f32x4*)(kp_ + 4), b0_ = *(const f32x4*)vp_, b1_ = *(const f32x4*)(vp_ + 4); \
            kreg.x = pk2(a0_[0], a0_[1]); kreg.y = pk2(a0_[2], a0_[3]); kreg.z = pk2(a1_[0], a1_[1]); kreg.w = pk2(a1_[2], a1_[3]); \
            vreg.x = pk2(b0_[0], b0_[1]); vreg.y = pk2(b0_[2], b0_[3]); vreg.z = pk2(b1_[0], b1_[1]); vreg.w = pk2(b1_[2], b1_[3]); \
        } else { const int kr_ = (cK != nullptr) ? 0 : (kt_) * 64; \
            kreg = *(const u32x4*)(K + (size_t)(kr_ + krow_l) * 1024 + kch * 8); vreg = *(const u32x4*)(V + (size_t)(kr_ + lane) * 1024 + wid * 8); } \
        if (type == 1 && tid < 64) fkreg = fk[(size_t)((kt_) * 64 + tid) * 8] * LOG2E; \
        kregs[rs_] = kreg; vregs[rs_] = vreg; fkregs[rs_] = fkreg; } while (0)
#define AT_LSTORE(rs_, buf_) do { const u32x4 kreg = kregs[rs_], vreg = vregs[rs_]; const float fkreg = fkregs[rs_]; *(LAS u32x4*)(ldsK + (buf_) * TILE_B + kst * 144 + kch * 16) = kreg; \
        LAS unsigned short* vd_ = (LAS unsigned short*)(ldsV + (buf_) * TILE_B + (wid * 8) * 144 + lane * 2); \
        vd_[0] = (unsigned short)(vreg.x & 0xffffu); vd_[72] = (unsigned short)(vreg.x >> 16); vd_[144] = (unsigned short)(vreg.y & 0xffffu); vd_[216] = (unsigned short)(vreg.y >> 16); \
        vd_[288] = (unsigned short)(vreg.z & 0xffffu); vd_[360] = (unsigned short)(vreg.z >> 16); vd_[432] = (unsigned short)(vreg.w & 0xffffu); vd_[504] = (unsigned short)(vreg.w >> 16); \
        if (type == 1 && tid < 64) fkt[(buf_) * 64 + tid] = fkreg; } while (0)
    AT_GLOAD(0, kt_hi); AT_LSTORE(0, 0); __syncthreads();
    if (kt_hi >= 1) AT_GLOAD(1, kt_hi - 1);
    int kt = kt_hi;
    for (;;) {
#pragma unroll
      for (int buf = 0; buf < 2; ++buf) {
        if (kt >= 2) AT_GLOAD(buf, kt - 2);
        if (!wave_done && kt <= wkt) {
            const LAS unsigned char* Kb = ldsK + buf * TILE_B; const LAS unsigned char* Vb = ldsV + buf * TILE_B;
            f32x16 s0, s1;
            { const float ci = type == 1 ? fq2 : 0.f;
#pragma unroll
                for (int r = 0; r < 16; ++r) { s0[r] = ci; s1[r] = ci; } }
            {   bf16x8 ka[4], kb[4];
#pragma unroll
                for (int d0 = 0; d0 < 4; ++d0) { ka[d0] = *(const LAS bf16x8*)(Kb + prow * 144 + (d0 * 16 + hi * 8) * 2); kb[d0] = *(const LAS bf16x8*)(Kb + (32 + prow) * 144 + (d0 * 16 + hi * 8) * 2); }
                __builtin_amdgcn_s_setprio(1);
#pragma unroll
                for (int d0 = 0; d0 < 4; ++d0) { s0 = MFMA32(ka[d0], qr[d0], s0); s1 = MFMA32(kb[d0], qr[d0], s1); }
                __builtin_amdgcn_s_setprio(0);
            }
            const int kvb = kt * 64 + 16 * hi;
            if (type == 1) {
                const LAS f32x4* fk4 = (const LAS f32x4*)(fkt + buf * 64 + 16 * hi);
#pragma unroll
                for (int g = 0; g < 4; ++g) { const f32x4 a = fk4[g], b = fk4[8 + g];
#pragma unroll
                    for (int e = 0; e < 4; ++e) { s0[4 * g + e] -= a[e]; s1[4 * g + e] -= b[e]; } }
                if (kt * 64 + 63 > qpos0 + wid * 32) {
#pragma unroll
                    for (int r = 0; r < 16; ++r) { if (kvb + r > qpos) s0[r] = -INFINITY; if (kvb + 32 + r > qpos) s1[r] = -INFINITY; }
                }
                if (bound) {
                    if (kt == wkt) { float mx = __builtin_fmaxf(s0[0], s1[0]);
#pragma unroll
                        for (int r = 1; r < 16; ++r) mx = __builtin_fmaxf(mx, __builtin_fmaxf(s0[r], s1[r]));
                        mrun = __builtin_fmaxf(mx, __shfl_xor(mx, 32)); }
                    float ps = 0.f;
#pragma unroll
                    for (int r = 0; r < 16; ++r) { s0[r] = ex2(s0[r]); s1[r] = ex2(s1[r]); ps += s0[r] + s1[r]; }
                    lrun += ps;
                } else {
                    float mx = __builtin_fmaxf(s0[0], s1[0]);
#pragma unroll
                    for (int r = 1; r < 16; ++r) mx = __builtin_fmaxf(mx, __builtin_fmaxf(s0[r], s1[r]));
                    mx = __builtin_fmaxf(mx, __shfl_xor(mx, 32));
                    const float mnew = __builtin_fmaxf(mrun, mx), alpha = ex2(mrun - mnew); mrun = mnew;
                    float ps = 0.f;
#pragma unroll
                    for (int r = 0; r < 16; ++r) { s0[r] = ex2(s0[r] - mnew); s1[r] = ex2(s1[r] - mnew); ps += s0[r] + s1[r]; }
                    lrun = lrun * alpha + ps;
                    if (__any(alpha != 1.0f)) {
#pragma unroll
                        for (int r = 0; r < 16; ++r) { o0[r] *= alpha; o1[r] *= alpha; } }
                }
            } else {
                f32x16 l0, l1; float T0 = 0.f, T1 = 0.f;
#pragma unroll
                for (int r = 0; r < 16; ++r) {
                    const float t0 = s0[r], t1 = s1[r];
                    float k0 = -(fmaxf(t0, 0.f) + lg2(1.0f + ex2(-fabsf(t0)))), k1 = -(fmaxf(t1, 0.f) + lg2(1.0f + ex2(-fabsf(t1))));
                    if (!(kvb + r < qpos)) k0 = 0.f;
                    if (!(kvb + 32 + r < qpos)) k1 = 0.f;
                    l0[r] = k0; l1[r] = k1; T0 += k0; T1 += k1;
                }
                const float U0 = __shfl_xor(T0, 32), U1 = __shfl_xor(T1, 32);
                float run = carry + (hi ? 0.f : U1);
#pragma unroll
                for (int r = 15; r >= 0; --r) { run += l1[r]; float a = ex2(s1[r] + run); if (!(kvb + 32 + r < qpos)) a = 0.f; s1[r] = a; }
                run = carry + (hi ? (T1 + U1) : (U1 + T1 + U0));
#pragma unroll
                for (int r = 15; r >= 0; --r) { run += l0[r]; float a = ex2(s0[r] + run); if (!(kvb + r < qpos)) a = 0.f; s0[r] = a; }
                carry += (T0 + T1) + (U0 + U1);
            }
#pragma unroll
            for (int c = 0; c < 4; ++c) {
                u32x4 pw;
                if (c == 0)      { pw.x = pk2(s0[0], s0[1]); pw.y = pk2(s0[2], s0[3]); pw.z = pk2(s0[4], s0[5]); pw.w = pk2(s0[6], s0[7]); }
                else if (c == 1) { pw.x = pk2(s0[8], s0[9]); pw.y = pk2(s0[10], s0[11]); pw.z = pk2(s0[12], s0[13]); pw.w = pk2(s0[14], s0[15]); }
                else if (c == 2) { pw.x = pk2(s1[0], s1[1]); pw.y = pk2(s1[2], s1[3]); pw.z = pk2(s1[4], s1[5]); pw.w = pk2(s1[6], s1[7]); }
                else             { pw.x = pk2(s1[8], s1[9]); pw.y = pk2(s1[10], s1[11]); pw.z = pk2(s1[12], s1[13]); pw.w = pk2(s1[14], s1[15]); }
                const bf16x8 pf = __builtin_bit_cast(bf16x8, pw);
                const int kvoff = 32 * (c >> 1) + 16 * hi + 8 * (c & 1);
                const bf16x8 va = *(const LAS bf16x8*)(Vb + r32 * 144 + kvoff * 2);
                const bf16x8 vb = *(const LAS bf16x8*)(Vb + (32 + r32) * 144 + kvoff * 2);
                o0 = MFMA32(va, pf, o0); o1 = MFMA32(vb, pf, o1);
            }
            if (type == 0) wave_done = __all(carry < -40.0f);
            else wave_done = __all((bound ? 0.f : qn) + fq2 - fkt[buf * 64] - mrun < -40.0f);
        }
        if (lane == 0) flags[buf * 8 + wid] = wave_done ? 1 : 0;
        if (kt >= 1) AT_LSTORE(buf ^ 1, buf ^ 1);
        __syncthreads();
        { int alld = 1;
#pragma unroll
            for (int w = 0; w < 8; ++w) alld &= flags[buf * 8 + w];
            if (alld) goto at_done; }
        if (--kt < 0) goto at_done;
      }
    }
at_done:
#undef AT_GLOAD
#undef AT_LSTORE
    if (wactive) {
        if (type == 1) { const float lt = lrun + __shfl_xor(lrun, 32); const float inv = 1.0f / lt;
#pragma unroll
            for (int r = 0; r < 16; ++r) { o0[r] *= inv; o1[r] *= inv; } }
        float sq = 0.f;
#pragma unroll
        for (int r = 0; r < 16; ++r) sq += o0[r] * o0[r] + o1[r] * o1[r];
        sq += __shfl_xor(sq, 32);
        if (hi == 0) ss[(size_t)qrow * 16] = sq;
        bf16_t* orow = O + (size_t)qrow * 1024 + 4 * hi;
#pragma unroll
        for (int g = 0; g < 4; ++g) {
            u32x2 w0, w1; w0.x = pk2(o0[4 * g], o0[4 * g + 1]); w0.y = pk2(o0[4 * g + 2], o0[4 * g + 3]); w1.x = pk2(o1[4 * g], o1[4 * g + 1]); w1.y = pk2(o1[4 * g + 2], o1[4 * g + 3]);
            *(u32x2*)(orow + 8 * g) = w0; *(u32x2*)(orow + 32 + 8 * g) = w1;
        }
    }
}

DI void transpose_item(const float* W, int K, int N, bf16_t* WT, int dst_row, int k0, int n0, LAS float* scr, int lane, const float* gk = nullptr, bool has_g = false) {
    float tv[32];
#pragma unroll
    for (int i = 0; i < 32; ++i) tv[i] = W[(size_t)(k0 + 2 * i + (lane >> 5)) * N + n0 + (lane & 31)];
    if (has_g) {
#pragma unroll
        for (int i = 0; i < 32; ++i) tv[i] *= gk[2 * i + (lane >> 5)]; }
#pragma unroll
    for (int i = 0; i < 32; ++i) scr[(2 * i + (lane >> 5)) * 33 + (lane & 31)] = tv[i];
    asm volatile("s_waitcnt lgkmcnt(0)" ::: "memory");
    const int c = lane & 7;
#pragma unroll
    for (int j = 0; j < 4; ++j) { const int n = (lane >> 3) + 8 * j; const LAS float* s = scr + (8 * c) * 33 + n;
        u32x4 o; o.x = pk2(s[0 * 33], s[1 * 33]); o.y = pk2(s[2 * 33], s[3 * 33]); o.z = pk2(s[4 * 33], s[5 * 33]); o.w = pk2(s[6 * 33], s[7 * 33]);
        *(u32x4*)(WT + (size_t)(dst_row + n) * K + k0 + 8 * c) = o; }
    asm volatile("s_waitcnt lgkmcnt(0)" ::: "memory");
}
DI void load_row(f32x4 (&v)[4], const float* x, int lane) {
    const f32x4* xr = (const f32x4*)x + lane;
#pragma unroll
    for (int j = 0; j < 4; ++j) v[j] = xr[64 * j];
}
DI void load_row_bf16(f32x4 (&v)[4], const bf16_t* x, int lane) {
#pragma unroll
    for (int j = 0; j < 4; ++j) { const u32x2 w = *(const u32x2*)(x + 4 * lane + 256 * j); v[j][0] = __uint_as_float(w.x << 16); v[j][1] = __uint_as_float(w.x & 0xffff0000u); v[j][2] = __uint_as_float(w.y << 16); v[j][3] = __uint_as_float(w.y & 0xffff0000u); }
}
DI void load_raw_bf16(u32x2 (&w)[4], const bf16_t* x, int lane) {
#pragma unroll
    for (int j = 0; j < 4; ++j) w[j] = *(const u32x2*)(x + 4 * lane + 256 * j);
}
DI void cvt_raw_bf16(f32x4 (&v)[4], const u32x2 (&w)[4]) {
#pragma unroll
    for (int j = 0; j < 4; ++j) { v[j][0] = __uint_as_float(w[j].x << 16); v[j][1] = __uint_as_float(w[j].x & 0xffff0000u); v[j][2] = __uint_as_float(w[j].y << 16); v[j][3] = __uint_as_float(w[j].y & 0xffff0000u); }
}
DI void add_parts(f32x4 (&v)[4], const float* pA, const float* pB, int S, int srow, const float* gate, int lane) {
#pragma unroll
    for (int j = 0; j < 4; ++j) { const int c = 4 * lane + 256 * j; f32x4 sum = {0.f, 0.f, 0.f, 0.f};
        for (int sp = 0; sp < S; ++sp) sum += *(const f32x4*)((sp < 8 ? pA + (size_t)sp * 1048576 : pB + (size_t)(sp - 8) * 1048576) + (size_t)srow * 1024 + c);
        v[j] += (*(const f32x4*)(gate + c) + 1.0f) * sum; }
}
DI void add_parts6(f32x4 (&v)[4], const float* pA, int srow, const float* gate, float r_sb, float r_fx, int lane) {
#pragma unroll
    for (int j = 0; j < 4; ++j) { const int c = 4 * lane + 256 * j; f32x4 sa = {0.f, 0.f, 0.f, 0.f}, sb = {0.f, 0.f, 0.f, 0.f};
#pragma unroll
        for (int sp = 0; sp < 4; ++sp) { sa += *(const f32x4*)(pA + (size_t)sp * 1048576 + (size_t)srow * 1024 + c); sb += *(const f32x4*)(pA + (size_t)(sp + 4) * 1048576 + (size_t)srow * 1024 + c); }
        v[j] += (*(const f32x4*)(gate + c) + 1.0f) * (sa * r_sb + sb * r_fx); }
}
DI float row_rstd(const f32x4 (&v)[4]) {
    float s = 0.f;
#pragma unroll
    for (int j = 0; j < 4; ++j) s += (v[j][0] * v[j][0] + v[j][1] * v[j][1]) + (v[j][2] * v[j][2] + v[j][3] * v[j][3]);
    return 1.0f / sqrtf(wave_sum(s) * (1.0f / 1024.0f) + EPS);
}
DI void norm_store_bf16(const f32x4 (&v)[4], const float* g, const float* scale, const float* shift, bf16_t* o, int lane) {
    const float rstd = row_rstd(v);
#pragma unroll
    for (int j = 0; j < 4; ++j) { const int c = 4 * lane + 256 * j; const f32x4 gv = *(const f32x4*)(g + c), sc = *(const f32x4*)(scale + c), sh = *(const f32x4*)(shift + c);
        const f32x4 r = (v[j] * rstd * gv) * (sc + 1.0f) + sh; u32x2 w; w.x = pk2(r[0], r[1]); w.y = pk2(r[2], r[3]); *(u32x2*)(o + c) = w; }
}
DI void norm_store_f32(const f32x4 (&v)[4], const float* g, float* o, int lane) {
    const float rstd = row_rstd(v);
#pragma unroll
    for (int j = 0; j < 4; ++j) { const int c = 4 * lane + 256 * j; const f32x4 gv = *(const f32x4*)(g + c); *(f32x4*)(o + c) = v[j] * rstd * gv; }
}

struct Args { const float* in[22]; float* out; unsigned char* ws; int ph_lo, ph_hi; };
enum { I_XP = 0, I_XS, I_CP, I_CS, I_CSBK, I_CSBV, I_CFXK, I_CFXV, I_CLF, I_WADA, I_BADA, I_GMIX, I_WIN, I_BF, I_GSB, I_GFX, I_WO, I_GFFN, I_WG, I_WU, I_WD, I_GFIN };
constexpr int NPHASE = 11;

__global__ void __launch_bounds__(512, 2) mk_fwd(Args a) {
    extern __shared__ __attribute__((aligned(16))) unsigned char lds_raw[];
    LAS unsigned char* lds = (LAS unsigned char*)lds_raw;
    cg::grid_group grid = cg::this_grid();
    const int tid = threadIdx.x, lane = tid & 63, wave = __builtin_amdgcn_readfirstlane(tid >> 6);
    const int G = gridDim.x, bid = blockIdx.x;
    const int gw = bid * 8 + wave, NGW = G * 8;
    unsigned char* ws = a.ws; float* out = a.out;
    float* ada = (float*)(ws + WS_ADA); float* fcp = (float*)(ws + WS_FCP); float* fcs = (float*)(ws + WS_FCS); float* ssb = (float*)(ws + WS_SS);
    bf16_t* WinT = (bf16_t*)(ws + WS_WIN); bf16_t* WoT = (bf16_t*)(ws + WS_WO); bf16_t* WguT = (bf16_t*)(ws + WS_WGU); bf16_t* WdT = (bf16_t*)(ws + WS_WD);
    bf16_t* Hn = (bf16_t*)(ws + WS_HN); bf16_t* Qb = (bf16_t*)(ws + WS_QB); bf16_t* Kp = (bf16_t*)(ws + WS_KP); bf16_t* Vp = (bf16_t*)(ws + WS_VP);
    bf16_t* Ks = (bf16_t*)(ws + WS_KS); bf16_t* Vs = (bf16_t*)(ws + WS_VS); bf16_t* Hff = (bf16_t*)(ws + WS_HFF); bf16_t* X1 = (bf16_t*)(ws + WS_X1);
    unsigned* kmax2 = (unsigned*)(ws + WS_KMAX); unsigned* uctr = (unsigned*)(ws + WS_CTR);
    float* part6 = (float*)(ws + 100 * MiB);
    float* part9a = (float*)(ws + WS_HN); float* part9b = (float*)(ws + 160 * MiB);
    const int lo = a.ph_lo, hi_ph = a.ph_hi;
#define IN(k) (lo <= (k) && (k) < hi_ph)
#ifndef REP_SYNC
#define REP_SYNC 1
#endif
#define SEAM(k) do { if (IN(k) && IN((k) + 1)) { for (int rs_ = 0; rs_ < REP_SYNC; ++rs_) xcd_barrier(xbar); } } while (0)
    LAS unsigned* misc = (LAS unsigned*)(lds + 131072);
    if (tid < 16) misc[tid] = 0u;
    __syncthreads();
    XcdBarrier xbar = xcd_barrier_post((unsigned*)(ws + WS_BAR), (volatile LAS unsigned*)(misc + 8));
    if (lo < 0) grid.sync();

    if (IN(0)) {
        for (int cb = bid; cb < 192; cb += G) {
            LAS float* sil = (LAS float*)lds;
            LAS float* red = (LAS float*)(lds + 73728);
            for (int i = tid; i < 18 * 1024; i += 512) { const int b = i >> 10, k = i & 1023; const float c = b < 2 ? a.in[I_CP][b * 1024 + k] : a.in[I_CS][(b - 2) * 1024 + k]; sil[i] = c / (1.0f + expf(-c)); }
            __syncthreads();
            const int kg = tid >> 3, c4 = tid & 7, col0 = cb * 32;
            f32x4 acc[18];
#pragma unroll
            for (int b = 0; b < 18; ++b) acc[b] = (f32x4){0.f, 0.f, 0.f, 0.f};
            const float* wp = a.in[I_WADA] + (size_t)kg * 6144 + col0 + 4 * c4;
#pragma unroll 2
            for (int i = 0; i < 16; ++i) { const f32x4 w4 = *(const f32x4*)(wp + (size_t)i * 64 * 6144); const int k = kg + 64 * i;
#pragma unroll
                for (int b = 0; b < 18; ++b) acc[b] += w4 * sil[b * 1024 + k]; }
#pragma unroll
            for (int b = 0; b < 18; ++b)
#pragma unroll
                for (int e = 0; e < 4; ++e) { float v = acc[b][e]; v += __shfl_xor(v, 8); v += __shfl_xor(v, 16); v += __shfl_xor(v, 32); acc[b][e] = v; }
            if (lane < 8) {
#pragma unroll
                for (int b = 0; b < 18; ++b) *(LAS f32x4*)(red + ((wave * 8 + lane) * 18 + b) * 4) = acc[b]; }
            __syncthreads();
            for (int o = tid; o < 18 * 32; o += 512) { const int b = o >> 5, c = o & 31; float sum = a.in[I_BADA][col0 + c];
#pragma unroll
                for (int w = 0; w < 8; ++w) sum += red[((w * 8 + (c >> 2)) * 18 + b) * 4 + (c & 3)];
                ada[(size_t)b * 6144 + col0 + c] = sum; }
            __syncthreads();
        }
        {
            LAS float* scr = (LAS float*)(lds + 8192 + wave * 8448);
            for (int it = gw; it < 16 * 96; it += NGW) { const int kb = it / 96, nb = it % 96; transpose_item(a.in[I_WIN], 1024, NIN, WinT, nb * 32, kb * 64, nb * 32, scr, lane); }
            for (int i = bid * 512 + tid; i < 8 * 1024; i += G * 512) { const int j = i >> 10, k = i & 1023; const float w = a.in[I_WIN][(size_t)k * NIN + 3072 + j];
                WinT[(size_t)(3072 + j) * 1024 + k] = (bf16_t)(pk2(w, 0.f) & 0xffffu); }
        }
    }
    SEAM(0);
    if (IN(1)) {
        int ln = lane; asm volatile("" : "+v"(ln));
        {
            f32x4 S0[4], S1[4], S2[4], S3[4]; int r = gw;
#define P1_LD(S, k) load_row(S, a.in[I_XP] + (size_t)min(r + (k) * NGW, MP - 1) * 1024, ln)
#define P1_DO(S, k) do { const int row = min(r + (k) * NGW, MP - 1); const float* ad = ada + (size_t)(row >> 13) * 6144; norm_store_bf16(S, a.in[I_GMIX], ad + 1024, ad, Hn + (size_t)row * 1024, ln); } while (0)
            P1_LD(S0, 0); P1_LD(S1, 1); P1_LD(S2, 2); P1_LD(S3, 3);
            for (; r < MP; r += 4 * NGW) { P1_DO(S0, 0); P1_LD(S0, 4); P1_DO(S1, 1); P1_LD(S1, 5); P1_DO(S2, 2); P1_LD(S2, 6); P1_DO(S3, 3); P1_LD(S3, 7); }
#undef P1_LD
#undef P1_DO
        }
        for (int row = MP + gw; row < M; row += NGW) { const float* ad = ada + (size_t)row_batch(row) * 6144;
            f32x4 v[4]; load_row(v, a.in[I_XS] + (size_t)(row - MP) * 1024, ln); norm_store_bf16(v, a.in[I_GMIX], ad + 1024, ad, Hn + (size_t)row * 1024, ln); }
    }
    SEAM(1);
    if (IN(2)) {
        pg8::Gemm g{Hn, WinT, M, NINP, 1024}; pg8::StaticOrder S; S.init(M, NINP, G, bid, 1024);
        EpiIn E{out, Qb, ws, a.in[I_BF]};
        pg8::gemm_phase<EpiIn, pg8::StaticOrder, true, true>(lds, g, S, E);
        {
            const int rem = S.nwg % G, nidle = rem ? G - rem : G, iw = rem ? bid - rem : bid;
            if (iw >= 0) {
                __syncthreads();
                LAS float* scr = (LAS float*)(lds + wave * 8448);
                constexpr int I_O = 16 * 32, I_G = 16 * 88, I_D = 44 * 32, NIT = I_O + 2 * I_G + I_D;
                for (int it = iw * 8 + wave; it < NIT; it += nidle * 8) {
                    int r = it;
                    if (r < I_O) { const int kb = r / 32, nb = r % 32; transpose_item(a.in[I_WO], 1024, 1024, WoT, nb * 32, kb * 64, nb * 32, scr, lane, kb < 8 ? a.in[I_GSB] + kb * 64 : a.in[I_GFX] + (kb - 8) * 64, true); continue; } r -= I_O;
                    if (r < I_G) { const int kb = r / 88, nb = r % 88, n0 = nb * 32; transpose_item(a.in[I_WG], 1024, DFF, WguT, 256 * (n0 >> 7) + (n0 & 127), kb * 64, n0, scr, lane); continue; } r -= I_G;
                    if (r < I_G) { const int kb = r / 88, nb = r % 88, n0 = nb * 32; transpose_item(a.in[I_WU], 1024, DFF, WguT, 256 * (n0 >> 7) + 128 + (n0 & 127), kb * 64, n0, scr, lane); continue; } r -= I_G;
                    { const int kb = r / 32, nb = r % 32; transpose_item(a.in[I_WD], DFF, 1024, WdT, nb * 32, kb * 64, nb * 32, scr, lane); }
                }
            }
        }
    }
    SEAM(2);
    if (IN(3)) {
        LAS float* sm = (LAS float*)lds; LAS float* sm2 = sm + 128;
        for (int job = bid; job < 144 + 256; job += G) {
            if (job < 144) {
                const bool pr = job < 64; int b, c; if (pr) { b = job >> 5; c = job & 31; } else { const int j = job - 64; b = j / 5; c = j - 5 * b; }
                const float* srcA = pr ? out + O_LFP + (size_t)b * TP * 8 : a.in[I_CLF] + (size_t)b * 1024 * 8;
                f32x4 ps = {0.f, 0.f, 0.f, 0.f};
                const f32x4* s4 = (const f32x4*)srcA;
                for (int i0 = 0; i0 < c; i0 += 8) {
                    f32x4 t[8];
#pragma unroll
                    for (int j = 0; j < 8; ++j) { t[j] = (f32x4){0.f, 0.f, 0.f, 0.f}; if (i0 + j < c) t[j] = s4[tid + 512 * (i0 + j)]; }
                    ps += ((t[0] + t[1]) + (t[2] + t[3])) + ((t[4] + t[5]) + (t[6] + t[7])); }
#pragma unroll
                for (int off = 2; off < 64; off <<= 1) { ps[0] += __shfl_xor(ps[0], off); ps[1] += __shfl_xor(ps[1], off); ps[2] += __shfl_xor(ps[2], off); ps[3] += __shfl_xor(ps[3], off); }
                if (lane < 2) *(LAS f32x4*)(sm + (wave * 2 + lane) * 4) = ps;
                const int nrows = (pr || c < 4) ? 256 : 64;
                float v[8];
#pragma unroll
                for (int e = 0; e < 8; ++e) v[e] = 0.f;
                if (tid < nrows) { const float* rp = (pr || c < 4) ? srcA + (size_t)(256 * c + tid) * 8 : out + O_LFS + ((size_t)b * 64 + tid) * 8;
                    const f32x4 v0 = *(const f32x4*)rp, v1 = *(const f32x4*)(rp + 4); v[0] = v0[0]; v[1] = v0[1]; v[2] = v0[2]; v[3] = v0[3]; v[4] = v1[0]; v[5] = v1[1]; v[6] = v1[2]; v[7] = v1[3]; }
#pragma unroll
                for (int off = 1; off < 64; off <<= 1) {
#pragma unroll
                    for (int e = 0; e < 8; ++e) { const float n = __shfl_up(v[e], off); if (lane >= off) v[e] += n; } }
                if (lane == 63) {
#pragma unroll
                    for (int e = 0; e < 8; ++e) sm2[wave * 8 + e] = v[e]; }
                __syncthreads();
#pragma unroll
                for (int e = 0; e < 8; ++e) { float p = 0.f;
#pragma unroll
                    for (int w = 0; w < 8; ++w) p += sm[(w * 2 + (e >> 2)) * 4 + (e & 3)];
                    for (int w = 0; w < wave; ++w) p += sm2[w * 8 + e];
                    v[e] += p; }
                if (tid < nrows) { float* dp = (pr ? fcp + ((size_t)b * TP + 256 * c + tid) * 8 : fcs + ((size_t)b * TS + 256 * c + tid) * 8);
                    *(f32x4*)dp = (f32x4){v[0], v[1], v[2], v[3]}; *(f32x4*)(dp + 4) = (f32x4){v[4], v[5], v[6], v[7]}; }
                __syncthreads();
            } else {
                const int jb = job - 144, row = jb * 64 + (tid >> 3), h = tid & 7;
                const u32x4* kp = (const u32x4*)(Kp + (size_t)row * 1024 + 512 + h * 64);
                float sq = 0.f;
#pragma unroll
                for (int i = 0; i < 8; ++i) { const u32x4 w = kp[i];
                    const float f0 = __uint_as_float(w.x << 16), f1 = __uint_as_float(w.x & 0xffff0000u), f2 = __uint_as_float(w.y << 16), f3 = __uint_as_float(w.y & 0xffff0000u);
                    const float f4 = __uint_as_float(w.z << 16), f5 = __uint_as_float(w.z & 0xffff0000u), f6 = __uint_as_float(w.w << 16), f7 = __uint_as_float(w.w & 0xffff0000u);
                    sq += (f0 * f0 + f1 * f1) + (f2 * f2 + f3 * f3) + (f4 * f4 + f5 * f5) + (f6 * f6 + f7 * f7); }
                sq = fmaxf(sq, __shfl_xor(sq, 8)); sq = fmaxf(sq, __shfl_xor(sq, 16)); sq = fmaxf(sq, __shfl_xor(sq, 32));
                if (lane < 8) atomicMax(kmax2 + (row >> 13) * 8 + lane, __float_as_uint(sq));
            }
        }
    }
    SEAM(3);
    if (IN(4)) for (int rep = 0; rep < REP_ATT; ++rep) {
        if (rep) { xcd_barrier(xbar); if (bid == 0 && tid == 0) __hip_atomic_store(uctr, 0u, __ATOMIC_RELAXED, __HIP_MEMORY_SCOPE_AGENT); xcd_barrier(xbar); }
        LAS int* uslot = (LAS int*)(lds + 4 * TILE_B + 1024);
        for (int first = 1;; first = 0) {
            int u = bid;
            if (!first) {
                if (tid == 0) *uslot = (int)atomicAdd(uctr, 1u) + G;
                __syncthreads();
                u = __builtin_amdgcn_readfirstlane(*uslot);
                __syncthreads();
            }
            if (u >= 1280) break;
            int type, b, h, qb = 0; bool samp = false;
            if (u < 512) { type = 1; qb = 31 - (u >> 4); b = (u >> 3) & 1; h = u & 7; }
            else if (u < 640) { const int w = u - 512; samp = true; type = 1; b = w >> 3; h = w & 7; }
            else if (u < 1152) { const int w = u - 640; type = 0; qb = 31 - (w >> 4); b = (w >> 3) & 1; h = w & 7; }
            else { const int w = u - 1152; samp = true; type = 0; b = w >> 3; h = w & 7; }
            const int colo = type * 512 + h * 64;
            const size_t rb = (size_t)b * TP, q0 = samp ? (size_t)MP + (size_t)b * 64 : rb + (size_t)qb * 256, kb = (size_t)b * TS;
            const bf16_t* Kb_ = samp ? Ks + (size_t)b * 64 * 1024 + colo : Kp + rb * 1024 + colo;
            const bf16_t* Vb_ = samp ? Vs + (size_t)b * 64 * 1024 + colo : Vp + rb * 1024 + colo;
            const float* cK = nullptr; const float* cV = nullptr;
            if (samp) { cK = (type ? a.in[I_CFXK] : a.in[I_CSBK]) + (size_t)b * 1024 * 512 + h * 64; cV = (type ? a.in[I_CFXV] : a.in[I_CSBV]) + (size_t)b * 1024 * 512 + h * 64; }
            const float kmn = (!samp && type == 1) ? sqrtf(__uint_as_float(kmax2[b * 8 + h])) : INFINITY;
            const float* fqp = samp ? fcs + (kb + 1024) * 8 + h : fcp + q0 * 8 + h; const float* fkp = samp ? fcs + kb * 8 + h : fcp + rb * 8 + h;
            attn_unit(lds, type, Qb + q0 * 1024 + colo, Kb_, Vb_, cK, cV, Hn + q0 * 1024 + colo, ssb + q0 * 16 + type * 8 + h, fqp, fkp, samp ? 1024 : qb * 256, samp ? 64 : 256, kmn);
        }
    }
    SEAM(4);
    if (IN(6)) {
        pg8::Gemm g{Hn, WoT, M, 1024, 1024}; TailOrder S; S.init(G, bid, 1024, 8);
        EpiRes<true> E{a.in[I_XP], ada, 2048, X1, 0, part6, part6, ssb};
        pg8::gemm_phase<EpiRes<true>, TailOrder, true, true>(lds, g, S, E);
    }
    SEAM(6);
    if (IN(7)) {
        int ln = lane; asm volatile("" : "+v"(ln));
        {
            u32x2 S0[4], S1[4], S2[4], S3[4]; int r = gw;
#define P7_LD(S, k) load_raw_bf16(S, X1 + (size_t)min(r + (k) * NGW, MP - 1) * 1024, ln)
#define P7_DO(S, k) do { const int row = min(r + (k) * NGW, MP - 1); const float* ad = ada + (size_t)(row >> 13) * 6144; f32x4 v[4]; cvt_raw_bf16(v, S); norm_store_bf16(v, a.in[I_GFFN], ad + 4096, ad + 3072, Hn + (size_t)row * 1024, ln); } while (0)
            P7_LD(S0, 0); P7_LD(S1, 1); P7_LD(S2, 2); P7_LD(S3, 3);
            for (; r < MP; r += 4 * NGW) { P7_DO(S0, 0); P7_LD(S0, 4); P7_DO(S1, 1); P7_LD(S1, 5); P7_DO(S2, 2); P7_LD(S2, 6); P7_DO(S3, 3); P7_LD(S3, 7); }
#undef P7_LD
#undef P7_DO
        }
        for (int row = MP + gw; row < M; row += NGW) { const float* ad = ada + (size_t)row_batch(row) * 6144;
            f32x4 v[4]; load_row(v, a.in[I_XS] + (size_t)(row - MP) * 1024, ln); float r_sb, r_fx; row_rstd2(ssb, row, r_sb, r_fx); add_parts6(v, part6, row - MP, ad + 2048, r_sb, r_fx, ln);
#pragma unroll
            for (int j = 0; j < 4; ++j) { u32x2 w; w.x = pk2(v[j][0], v[j][1]); w.y = pk2(v[j][2], v[j][3]); *(u32x2*)(X1 + (size_t)row * 1024 + 4 * ln + 256 * j) = w; }
            norm_store_bf16(v, a.in[I_GFFN], ad + 4096, ad + 3072, Hn + (size_t)row * 1024, ln); }
    }
    SEAM(7);
    if (IN(8)) {
        pg8::Gemm g{Hn, WguT, M, 2 * DFF, 1024}; pg8::StaticOrder S; S.init(M, 2 * DFF, G, bid, 1024);
        EpiUp E{Hff};
        pg8::gemm_phase<EpiUp, pg8::StaticOrder, true, true>(lds, g, S, E);
    }
    SEAM(8);
    if (IN(9)) {
        pg8::Gemm g{Hff, WdT, M, 1024, DFF}; TailOrder S; S.init(G, bid, DFF, 11);
        EpiRes<false> E{a.in[I_XP], ada, 5120, X1, 1, part9a, part9b, ssb};
        pg8::gemm_phase<EpiRes<false>, TailOrder, true, true>(lds, g, S, E);
    }
    SEAM(9);
    if (IN(10)) {
        int ln = lane; asm volatile("" : "+v"(ln));
        {
            u32x2 S0[4], S1[4], S2[4], S3[4]; int r = gw;
#define P10_LD(S, k) load_raw_bf16(S, X1 + (size_t)min(r + (k) * NGW, MP - 1) * 1024, ln)
#define P10_DO(S, k) do { const int row = min(r + (k) * NGW, MP - 1); f32x4 v[4]; cvt_raw_bf16(v, S); norm_store_f32(v, a.in[I_GFIN], out + O_YP + (size_t)row * 1024, ln); } while (0)
            P10_LD(S0, 0); P10_LD(S1, 1); P10_LD(S2, 2); P10_LD(S3, 3);
            for (; r < MP; r += 4 * NGW) { P10_DO(S0, 0); P10_LD(S0, 4); P10_DO(S1, 1); P10_LD(S1, 5); P10_DO(S2, 2); P10_LD(S2, 6); P10_DO(S3, 3); P10_LD(S3, 7); }
#undef P10_LD
#undef P10_DO
        }
        for (int row = MP + gw; row < M; row += NGW) { f32x4 v[4]; load_row_bf16(v, X1 + (size_t)row * 1024, ln);
            add_parts(v, part9a, part9b, 11, row - MP, ada + (size_t)row_batch(row) * 6144 + 5120, ln);
            norm_store_f32(v, a.in[I_GFIN], out + O_YS + (size_t)(row - MP) * 1024, ln); }
    }
#undef IN
#undef SEAM
}
}

extern "C" void kernel_launch(void* const* d_in, const int* in_sizes, int n_in, void* d_out, int out_size, void* d_ws, size_t ws_size, hipStream_t stream) {
    using namespace mk;
    static int grid = 0;
    if (grid == 0) {
        int dev = 0, cus = 0, per_cu = 0;
        (void)hipGetDevice(&dev); (void)hipDeviceGetAttribute(&cus, hipDeviceAttributeMultiprocessorCount, dev);
        if (hipFuncSetAttribute((const void*)mk_fwd, hipFuncAttributeMaxDynamicSharedMemorySize, LDS_BYTES) != hipSuccess) { fprintf(stderr, "kernel_launch: hipFuncSetAttribute failed\n"); grid = -1; return; }
        if (hipOccupancyMaxActiveBlocksPerMultiprocessor(&per_cu, (const void*)mk_fwd, 512, LDS_BYTES) != hipSuccess || per_cu < 1) { fprintf(stderr, "kernel_launch: occupancy query gave %d\n", per_cu); per_cu = 1; }
        (void)hipGetLastError();
        grid = cus * 1;
        if (grid <= 0) grid = 256;
    }
    if (grid < 0) return;
    (void)hipMemsetAsync((char*)d_ws + WS_BAR, 0, CTL_BYTES - WS_BAR, stream);
    Args a{};
    for (int i = 0; i < 22; ++i) a.in[i] = (const float*)d_in[i];
    a.out = (float*)d_out; a.ws = (unsigned char*)d_ws;
#if MK_MULTI
    for (int p = 0; p < NPHASE; ++p) { a.ph_lo = p; a.ph_hi = p + 1; hipLaunchKernelGGL(mk_fwd, dim3(grid), dim3(512), LDS_BYTES, stream, a); }
#else
    a.ph_lo = 0; a.ph_hi = NPHASE;
    void* args[] = {&a};
    hipError_t e = hipLaunchCooperativeKernel((const void*)mk_fwd, dim3(grid), dim3(512), args, LDS_BYTES, stream);
    if (e != hipSuccess) fprintf(stderr, "cooperative launch failed: %s (grid %d)\n", hipGetErrorString(e), grid);
#endif
}
```

```cpp
#include <hip/hip_runtime.h>
#include <hip/hip_cooperative_groups.h>
#include <cstdio>
#include <cstdint>
namespace cg = cooperative_groups;
namespace pg8 {
#define PG8_LAS __attribute__((address_space(3)))
typedef unsigned short bf16_t;
typedef short bf16x8 __attribute__((ext_vector_type(8)));
typedef float f32x4 __attribute__((ext_vector_type(4)));
typedef unsigned u32x4 __attribute__((ext_vector_type(4)));
constexpr int BM = 256, BK = 64, HALF = 128, HTB = HALF * BK * 2  , STAGE_BYTES = 8 * HTB, NXCD = 8, WGM = 8;

__host__ __device__ __forceinline__ int lds_byte(int r, int c) { const int st = (r >> 4) * 2 + (c >> 5), rr = r & 15, cc = c & 31, ob = rr * 64 + cc * 2; return st * 1024 + (ob ^ (((ob >> 9) & 1) << 5)); }
__host__ __device__ __forceinline__ void stage_rc(int b, int& R, int& C) { const int st = b / 1024, sb = b % 1024, swz = sb ^ (((sb >> 9) & 1) << 5); R = (st >> 1) * 16 + swz / 64; C = (st & 1) * 32 + (swz % 64) / 2; }
__host__ __device__ __forceinline__ int perm32(int rho) { const int n = rho >> 4, i = rho & 15; return 8 * (i >> 2) + 4 * n + (i & 3); }

struct Unit { int pm, pn, koff, nt; };
struct Gemm { const bf16_t* A; const bf16_t* Bt; int M, N, K; };

struct StaticOrder {
    int nM, nN, nwg, G, c, ntf;
    __host__ __device__ __forceinline__ void init(int M, int N, int G_, int c_, int K_) { nM = M / BM; nN = N / BM; nwg = nM * nN; G = G_; c = c_; ntf = K_ / BK; }
    __host__ __device__ __forceinline__ bool next(int i, Unit& u) const {
        const long L = (long)i * G + c; if (L >= nwg) return false;
        int wgid = (int)L; { const int q = nwg / NXCD, r = nwg % NXCD, xcd = wgid % NXCD, off = wgid / NXCD; wgid = (xcd < r ? xcd * (q + 1) : r * (q + 1) + (xcd - r) * q) + off; }
        const int nig = WGM * nN, gid = wgid / nig, fm = gid * WGM, gsz = (nM - fm) < WGM ? (nM - fm) : WGM;
        u.pm = fm + ((wgid % nig) % gsz); u.pn = (wgid % nig) / gsz; u.koff = 0; u.nt = ntf; return true;
    }
    __device__ __forceinline__ void a_ready(const Unit&) const {}
    __device__ __forceinline__ void done(const Unit&) const {}
};

template <class Epi, class Sched, bool ALIGN_EPI = false, bool SP2 = false>
__device__ __forceinline__ void gemm_phase(PG8_LAS unsigned char* lds, const Gemm g, const Sched& S, const Epi& E) {
    const int tid = threadIdx.x, wid = __builtin_amdgcn_readfirstlane(tid >> 6), lane = tid & 63, wr = wid >> 2, wc = wid & 3, fr = lane & 15, fq = lane >> 4;
    const int K = g.K;
    unsigned voffA[2], voffB[2];
#pragma unroll
    for (int i = 0; i < 2; ++i) { int R, C; stage_rc(tid * 16 + i * 8192, R, C); const int Rb = Epi::PERM ? ((R & ~31) + perm32(R & 31)) : R;
        voffA[i] = (unsigned)(R * K + C) * 2u; voffB[i] = (unsigned)(Rb * K + C) * 2u; }
    const size_t kstep = (size_t)(BK * 2);
    const size_t hstep = (size_t)HALF * K * 2;
    const size_t tstep = 2 * hstep;
    const unsigned ldsw = (unsigned)wid * 1024u;
    const int aoff = lds_byte(wr * 64 + fr, fq * 8), boff = lds_byte(wc * 32 + fr, fq * 8);
#define PG8_SA(b, h) (((b) * 2 + (h)) * HTB)
#define PG8_SB(b, h) ((4 + (b) * 2 + (h)) * HTB)
#define PG8_STAGE(bufoff, gbase, voff) do { _Pragma("unroll") for (int _i = 0; _i < 2; ++_i) \
        __builtin_amdgcn_global_load_lds((const unsigned*)((const char*)(gbase) + (voff)[_i]), (PG8_LAS unsigned*)(lds + (bufoff) + ldsw + _i * 8192), 16, 0, 0); } while (0)
#define PG8_LDA(dst, b, h) do { _Pragma("unroll") for (int m = 0; m < 4; ++m) _Pragma("unroll") for (int k = 0; k < 2; ++k) dst[m][k] = *(const PG8_LAS bf16x8*)(lds + PG8_SA(b, h) + aoff + m * 2048 + k * 1024); } while (0)
#define PG8_LDB(dst, b, h) do { _Pragma("unroll") for (int n = 0; n < 2; ++n) _Pragma("unroll") for (int k = 0; k < 2; ++k) dst[n][k] = *(const PG8_LAS bf16x8*)(lds + PG8_SB(b, h) + boff + n * 2048 + k * 1024); } while (0)
#define PG8_MMA(ai, bj, At, Bt) do { __builtin_amdgcn_s_setprio(1); _Pragma("unroll") for (int m = 0; m < 4; ++m) _Pragma("unroll") for (int n = 0; n < 2; ++n) _Pragma("unroll") for (int k = 0; k < 2; ++k) \
        acc[ai][bj][m][n] = __builtin_amdgcn_mfma_f32_16x16x32_bf16(Bt[n][k], At[m][k], acc[ai][bj][m][n], 0, 0, 0); __builtin_amdgcn_s_setprio(0); } while (0)
#define PG8_WAIT_V(n) asm volatile("s_waitcnt vmcnt(" #n ")" ::: "memory")
#define PG8_WAIT_L(n) asm volatile("s_waitcnt lgkmcnt(" #n ")" ::: "memory")
#define PG8_BAR __builtin_amdgcn_s_barrier()
#define PG8_SCHED __builtin_amdgcn_sched_barrier(0)
    Unit cur, nxt; int ui = 0;
    if (!S.next(0, cur)) return;
    f32x4 acc[2][2][4][2];
#pragma unroll
    for (int a = 0; a < 2; ++a)
#pragma unroll
        for (int b = 0; b < 2; ++b)
#pragma unroll
            for (int m = 0; m < 4; ++m)
#pragma unroll
                for (int n = 0; n < 2; ++n) acc[a][b][m][n] = (f32x4){0.f, 0.f, 0.f, 0.f};
    bf16x8 At[4][2], B0[2][2], B1[2][2];
    const char* cA = (const char*)g.A + (size_t)cur.pm * tstep + (size_t)cur.koff * 2; const char* cB = (const char*)g.Bt + (size_t)cur.pn * tstep + (size_t)cur.koff * 2;
    S.a_ready(cur);
    if constexpr (SP2) {
        PG8_STAGE(PG8_SB(0, 0), cB, voffB); PG8_STAGE(PG8_SB(0, 1), cB + hstep, voffB); PG8_STAGE(PG8_SA(0, 0), cA, voffA); PG8_STAGE(PG8_SA(0, 1), cA + hstep, voffA);
        if (wr == 1) PG8_BAR;
        PG8_WAIT_V(2); PG8_BAR;
        PG8_STAGE(PG8_SB(1, 0), cB + kstep, voffB); PG8_STAGE(PG8_SA(1, 0), cA + kstep, voffA); PG8_STAGE(PG8_SB(1, 1), cB + hstep + kstep, voffB);
        PG8_WAIT_V(6); PG8_BAR;
    } else {
        PG8_STAGE(PG8_SB(0, 0), cB, voffB); PG8_STAGE(PG8_SA(0, 0), cA, voffA); PG8_STAGE(PG8_SB(0, 1), cB + hstep, voffB); PG8_STAGE(PG8_SA(0, 1), cA + hstep, voffA);
        if (wr == 1) PG8_BAR;
        PG8_WAIT_V(4); PG8_BAR;
        PG8_STAGE(PG8_SB(1, 0), cB + kstep, voffB); PG8_STAGE(PG8_SA(1, 0), cA + kstep, voffA); PG8_STAGE(PG8_SB(1, 1), cB + hstep + kstep, voffB);
        PG8_WAIT_V(6); PG8_BAR;
    }
    for (;;) {
        const bool has_next = S.next(ui + 1, nxt);
        const char* nA = has_next ? (const char*)g.A + (size_t)nxt.pm * tstep + (size_t)nxt.koff * 2 : cA; const char* nB = has_next ? (const char*)g.Bt + (size_t)nxt.pn * tstep + (size_t)nxt.koff * 2 : cB;
        const int nt = cur.nt;
        for (int t = 0; t < nt; t += 2) {
            const bool last = (t == nt - 2);
            if constexpr (Epi::MIDK) { if (t == Epi::MIDT && cur.pm < Epi::MIDPM) E.mid(acc, cur, wr, wc, fr, fq); }
            const char* a1 = cA + (size_t)(t + 1) * kstep;
            const char* a2 = last ? nA : cA + (size_t)(t + 2) * kstep; const char* b2 = last ? nB : cB + (size_t)(t + 2) * kstep;
            const char* a3 = a2 + kstep; const char* b3 = b2 + kstep;
            if (last && has_next) S.a_ready(nxt);
            if constexpr (SP2) {
            PG8_LDB(B0, 0, 0); PG8_LDB(B1, 0, 1); PG8_SCHED; PG8_LDA(At, 0, 0); PG8_STAGE(PG8_SA(1, 1), a1 + hstep, voffA);
            PG8_WAIT_V(8); PG8_WAIT_L(0); PG8_BAR; PG8_MMA(0, 0, At, B0); PG8_MMA(0, 1, At, B1); PG8_BAR; PG8_SCHED;
            PG8_LDA(At, 0, 1); PG8_STAGE(PG8_SB(0, 0), b2, voffB); PG8_STAGE(PG8_SB(0, 1), b2 + hstep, voffB); PG8_STAGE(PG8_SA(0, 0), a2, voffA);
            PG8_WAIT_V(8); PG8_WAIT_L(0); PG8_BAR; PG8_MMA(1, 0, At, B0); PG8_MMA(1, 1, At, B1); PG8_BAR; PG8_SCHED;
            PG8_LDB(B0, 1, 0); PG8_LDB(B1, 1, 1); PG8_SCHED; PG8_LDA(At, 1, 0); PG8_STAGE(PG8_SA(0, 1), a2 + hstep, voffA);
            PG8_WAIT_V(8); PG8_WAIT_L(0); PG8_BAR; PG8_MMA(0, 0, At, B0); PG8_MMA(0, 1, At, B1); PG8_BAR; PG8_SCHED;
            PG8_LDA(At, 1, 1); PG8_STAGE(PG8_SB(1, 0), b3, voffB); PG8_STAGE(PG8_SB(1, 1), b3 + hstep, voffB); PG8_STAGE(PG8_SA(1, 0), a3, voffA);
            PG8_WAIT_V(8); PG8_WAIT_L(0); PG8_BAR; PG8_MMA(1, 0, At, B0); PG8_MMA(1, 1, At, B1); PG8_BAR; PG8_SCHED;
            } else {
            PG8_LDB(B0, 0, 0); PG8_SCHED; PG8_LDA(At, 0, 0); PG8_STAGE(PG8_SA(1, 1), a1 + hstep, voffA);
            PG8_WAIT_L(8); PG8_BAR; PG8_WAIT_L(0); PG8_MMA(0, 0, At, B0); PG8_BAR; PG8_SCHED;
            PG8_LDB(B1, 0, 1); PG8_STAGE(PG8_SB(0, 0), b2, voffB);
            PG8_BAR; PG8_WAIT_L(0); PG8_MMA(0, 1, At, B1); PG8_BAR;
            PG8_LDA(At, 0, 1); PG8_STAGE(PG8_SA(0, 0), a2, voffA);
            PG8_BAR; PG8_WAIT_L(0); PG8_MMA(1, 0, At, B0); PG8_BAR; PG8_SCHED;
            PG8_STAGE(PG8_SB(0, 1), b2 + hstep, voffB);
            PG8_WAIT_V(6); PG8_BAR; PG8_MMA(1, 1, At, B1); PG8_BAR;
            PG8_LDB(B0, 1, 0); PG8_SCHED; PG8_LDA(At, 1, 0); PG8_STAGE(PG8_SA(0, 1), a2 + hstep, voffA);
            PG8_WAIT_L(8); PG8_BAR; PG8_WAIT_L(0); PG8_MMA(0, 0, At, B0); PG8_BAR; PG8_SCHED;
            PG8_LDB(B1, 1, 1); PG8_STAGE(PG8_SB(1, 0), b3, voffB);
            PG8_BAR; PG8_WAIT_L(0); PG8_MMA(0, 1, At, B1); PG8_BAR;
            PG8_LDA(At, 1, 1); PG8_STAGE(PG8_SA(1, 0), a3, voffA);
            PG8_BAR; PG8_WAIT_L(0); PG8_MMA(1, 0, At, B0); PG8_BAR; PG8_SCHED;
            PG8_STAGE(PG8_SB(1, 1), b3 + hstep, voffB);
            PG8_WAIT_V(6); PG8_BAR; PG8_MMA(1, 1, At, B1); PG8_BAR;
            }
        }
        if constexpr (ALIGN_EPI) { if (wr == 0) PG8_BAR; }
        if constexpr (!Epi::AFTER_DRAIN) { E(acc, cur, wr, wc, fr, fq); S.done(cur); }
        if (!has_next) break;
#pragma unroll
        for (int a = 0; a < 2; ++a)
#pragma unroll
            for (int b = 0; b < 2; ++b)
#pragma unroll
                for (int m = 0; m < 4; ++m)
#pragma unroll
                    for (int n = 0; n < 2; ++n) acc[a][b][m][n] = (f32x4){0.f, 0.f, 0.f, 0.f};
        cur = nxt; cA = nA; cB = nB; ++ui;
        if constexpr (ALIGN_EPI) { if (wr == 1) PG8_BAR; }
    }
    PG8_WAIT_V(0);
    if constexpr (!ALIGN_EPI) { if (wr == 0) PG8_BAR; }
    PG8_BAR;
    if constexpr (Epi::AFTER_DRAIN) { E.fused(acc, cur, wr, wc, fr, fq, lds, wid, lane); S.done(cur); }
#undef PG8_SA
#undef PG8_SB
#undef PG8_STAGE
#undef PG8_LDA
#undef PG8_LDB
#undef PG8_MMA
#undef PG8_WAIT_V
#undef PG8_WAIT_L
#undef PG8_BAR
#undef PG8_SCHED
}
}

#ifndef REP_ATT
#define REP_ATT 1
#endif
#ifndef REP_GEMM
#define REP_GEMM 1
#endif
#ifndef MK_MULTI
#define MK_MULTI 0
#endif
namespace mk {
using pg8::bf16_t; using pg8::bf16x8; using pg8::f32x4; using pg8::u32x4;
typedef float f32x16 __attribute__((ext_vector_type(16)));
typedef unsigned u32x2 __attribute__((ext_vector_type(2)));
#define LAS __attribute__((address_space(3)))
#define DI __device__ __forceinline__

#define XB_TMO      128
#define XB_XCNT(j)  (256  + 64 * (j))
#define XB_XSUB(j)  (1280 + 64 * (j))
#define XB_XGEN(j)  (2304 + 64 * (j))
#define XB_TOP      3328
#define XB_TOPGEN   3392
#define XCD_BAR_WORDS 3456
#define XB_SPIN_CAP (1u << 18)

__device__ __forceinline__ unsigned xb_ld(unsigned* p)              { return __hip_atomic_load(p, __ATOMIC_RELAXED, __HIP_MEMORY_SCOPE_AGENT); }
__device__ __forceinline__ unsigned xb_add(unsigned* p, unsigned v) { return __hip_atomic_fetch_add(p, v, __ATOMIC_RELAXED, __HIP_MEMORY_SCOPE_AGENT); }
__device__ __forceinline__ unsigned xb_xcc_id() { return (unsigned)__builtin_amdgcn_s_getreg((3 << 11) | 20) & 0xFu; }
#define XB_SPIN(cond, bar) do { unsigned _sp = 0; while (cond) { __builtin_amdgcn_s_sleep(1); \
    if ((++_sp & 255u) == 0u) { if (xb_ld(&(bar)[XB_TMO])) break; if (_sp > XB_SPIN_CAP) { atomicAdd(&(bar)[XB_TMO], 1u); break; } } } } while (0)

struct XcdBarrier {
    unsigned* bar; unsigned x;
    volatile LAS unsigned* st;
};

__device__ __forceinline__ XcdBarrier xcd_barrier_post(unsigned* bar, volatile LAS unsigned* st) {
    XcdBarrier b; b.bar = bar; b.x = xb_xcc_id(); b.st = st;
    if (threadIdx.x == 0) (void)xb_add(&bar[XB_XCNT(b.x)], 1u);
    return b;
}
__device__ __forceinline__ void xcd_barrier_complete(unsigned* bar, unsigned x, unsigned& nloc, unsigned& nx) {
    const unsigned G = gridDim.x * gridDim.y * gridDim.z;
    unsigned sum, cnt, mine, sp = 0u;
    for (;;) {
        sum = 0u; cnt = 0u; mine = 0u;
#pragma unroll
        for (unsigned j = 0; j < 16; ++j) { const unsigned c = xb_ld(&bar[XB_XCNT(j)]); sum += c; cnt += (c > 0u) ? 1u : 0u; mine = (j == x) ? c : mine; }
        if (sum == G) break;
        __builtin_amdgcn_s_sleep(1);
        if ((++sp & 255u) == 0u) { if (xb_ld(&bar[XB_TMO])) break; if (sp > XB_SPIN_CAP) { atomicAdd(&bar[XB_TMO], 1u); break; } }
    }
    nloc = mine > 0u ? mine : 1u; nx = cnt > 0u ? cnt : 1u;
}

__device__ __forceinline__ void xcd_barrier(const XcdBarrier& b) {
    asm volatile("s_waitcnt vmcnt(0)" ::: "memory");
    __syncthreads();
    if (threadIdx.x == 0) {
        unsigned* bar = b.bar;
        __builtin_amdgcn_s_waitcnt(0);
        unsigned nloc = b.st[0], nx = b.st[1];
        if (nloc == 0u) { xcd_barrier_complete(bar, b.x, nloc, nx); b.st[0] = nloc; b.st[1] = nx; }
        const unsigned old = xb_add(&bar[XB_XSUB(b.x)], 1u);
        const unsigned gen = old / nloc;
        if (old + 1u == (gen + 1u) * nloc) {
            __builtin_amdgcn_fence(__ATOMIC_RELEASE, "agent");
            asm volatile("s_waitcnt vmcnt(0)" ::: "memory");
            const unsigned og = xb_add(&bar[XB_TOP], 1u);
            const unsigned tg = og / nx;
            if (og + 1u == (tg + 1u) * nx) xb_add(&bar[XB_TOPGEN], 1u);
            else XB_SPIN(xb_ld(&bar[XB_TOPGEN]) == tg, bar);
            __builtin_amdgcn_fence(__ATOMIC_ACQUIRE, "agent");
            xb_add(&bar[XB_XGEN(b.x)], 1u);
            asm volatile("s_waitcnt vmcnt(0)" ::: "memory");
        } else {
            XB_SPIN(xb_ld(&bar[XB_XGEN(b.x)]) == gen, bar);
            __builtin_amdgcn_fence(__ATOMIC_ACQUIRE, "agent");
            asm volatile("s_waitcnt vmcnt(0)" ::: "memory");
        }
    }
    __syncthreads();
}

constexpr int MP = 16384, MS = 1024, M = MP + MS, D = 1024, NIN = 3080, NINP = 3328, DFF = 2816, TS = 1088, TP = 8192;
constexpr float LOG2E = 1.4426950408889634f, C2 = 0.125f * LOG2E, EPS = 1e-6f;
constexpr size_t O_YP = 0, O_YS = 16777216, O_SBKP = 17825792, O_LFP = 51380224, O_SBKS = 51511296, O_LFS = 53608448;
constexpr size_t KVP_SZ = 8388608, KVS_SZ = 524288;
constexpr size_t MiB = 1u << 20;
constexpr size_t WS_ADA = 0, ADA_BYTES = 18 * 6144 * 4, WS_BAR = 512 * 1024, WS_KMAX = WS_BAR + 16384, WS_CTR = WS_KMAX + 256, CTL_BYTES = WS_CTR + 256;
constexpr size_t WS_FCP = 1 * MiB, WS_FCS = 2 * MiB, WS_SS = 3 * MiB;
constexpr size_t WS_WIN = 5 * MiB, WS_WO = 12 * MiB, WS_WGU = 14 * MiB, WS_WD = 25 * MiB;
constexpr size_t WS_HN = 32 * MiB, WS_QB = 66 * MiB, WS_KP = 100 * MiB, WS_VP = 132 * MiB, WS_KS = 164 * MiB, WS_VS = 198 * MiB;
constexpr size_t WS_HFF = 66 * MiB;
constexpr size_t WS_X1 = 188 * MiB;
static_assert(WS_KP == 100 * MiB && WS_VP == 132 * MiB && WS_KS == 164 * MiB && WS_VS == 198 * MiB && WS_HFF + (size_t)M * DFF * 2 <= WS_X1 && WS_X1 + (size_t)M * D * 4 <= 256 * MiB, "ws map");
constexpr int LDS_BYTES = 135168;

DI unsigned pk2(float lo, float hi) { typedef float f2 __attribute__((ext_vector_type(2))); typedef __bf16 b2 __attribute__((ext_vector_type(2))); f2 v = {lo, hi}; b2 b = __builtin_convertvector(v, b2); return __builtin_bit_cast(unsigned, b); }
DI float bf2f(unsigned short b) { return __uint_as_float((unsigned)b << 16); }
DI float ex2(float x) { return __builtin_amdgcn_exp2f(x); }
DI float lg2(float x) { return __builtin_amdgcn_logf(x); }
DI float wave_sum(float v) {
#pragma unroll
    for (int o = 1; o < 64; o <<= 1) v += __shfl_xor(v, o);
    return v;
}
DI int row_batch(int row) { return row < MP ? (row >> 13) : 2 + ((row - MP) >> 6); }
DI float logsig(float x) { return fminf(x, 0.f) - log1pf(expf(-fabsf(x))); }

struct EpiIn {
    static constexpr bool PERM = false, AFTER_DRAIN = false, MIDK = false;
    float* out; bf16_t* Qb; unsigned char* ws; const float* b_f;
    DI void operator()(const f32x4 (&acc)[2][2][4][2], const pg8::Unit& u, int wr, int wc, int fr, int fq) const {
        const int pn = u.pn, type = pn >> 1, half = (pn & 1) * 256;
        if (type == 6) {
            if (wc == 0 && fq < 2) {
                const f32x4 bf = *(const f32x4*)(b_f + fq * 4);
#pragma unroll
                for (int ai = 0; ai < 2; ++ai)
#pragma unroll
                    for (int m = 0; m < 4; ++m) {
                        const int row = u.pm * 256 + ai * 128 + wr * 64 + m * 16 + fr;
                        const f32x4 v = acc[ai][0][m][0] + bf;
                        f32x4 lf; lf[0] = logsig(v[0]); lf[1] = logsig(v[1]); lf[2] = logsig(v[2]); lf[3] = logsig(v[3]);
                        float* dst = row < MP ? out + O_LFP + (size_t)row * 8 : out + O_LFS + (size_t)(row - MP) * 8;
                        *(f32x4*)(dst + fq * 4) = lf;
                    }
            }
            return;
        }
        const int cofs = half + wc * 32 + fq * 4;
        if (type == 0 || type == 3) {
#pragma unroll
            for (int ai = 0; ai < 2; ++ai)
#pragma unroll
                for (int m = 0; m < 4; ++m) {
                    const int row = u.pm * 256 + ai * 128 + wr * 64 + m * 16 + fr;
                    bf16_t* q = Qb + (size_t)row * 1024 + (type == 3 ? 512 : 0) + cofs;
#pragma unroll
                    for (int bj = 0; bj < 2; ++bj)
#pragma unroll
                        for (int n = 0; n < 2; ++n) { const f32x4 v = acc[ai][bj][m][n] * C2; u32x2 w; w.x = pk2(v[0], v[1]); w.y = pk2(v[2], v[3]); *(u32x2*)(q + bj * 128 + n * 16) = w; }
                }
            return;
        }
        const int isv = (type == 2 || type == 5) ? 1 : 0, grp = type >= 3 ? 1 : 0;
#pragma unroll
        for (int ai = 0; ai < 2; ++ai)
#pragma unroll
            for (int m = 0; m < 4; ++m) {
                const int row = u.pm * 256 + ai * 128 + wr * 64 + m * 16 + fr;
                const bool samp = row >= MP; const int s = row - MP;
                float* fo = out + (samp ? O_SBKS + (size_t)(isv + 2 * grp) * KVS_SZ + (size_t)s * 512 : O_SBKP + (size_t)(isv + 2 * grp) * KVP_SZ + (size_t)row * 512) + cofs;
                const size_t brow = samp ? (size_t)s : (size_t)row;
                bf16_t* bo = (bf16_t*)(ws + MiB * (size_t)(100 + 32 * isv + (samp ? 64 + 2 * isv : 0))) + brow * 1024 + grp * 512 + cofs;
#pragma unroll
                for (int bj = 0; bj < 2; ++bj)
#pragma unroll
                    for (int n = 0; n < 2; ++n) { const f32x4 v = acc[ai][bj][m][n]; *(f32x4*)(fo + bj * 128 + n * 16) = v; u32x2 w; w.x = pk2(v[0], v[1]); w.y = pk2(v[2], v[3]); *(u32x2*)(bo + bj * 128 + n * 16) = w; }
            }
    }
};
DI void row_rstd2(const float* ssb, int row, float& r_sb, float& r_fx) {
    const f32x4* sp = (const f32x4*)(ssb + (size_t)row * 16); const f32x4 s0 = sp[0], s1 = sp[1], s2 = sp[2], s3 = sp[3];
    r_sb = 1.0f / sqrtf(((s0[0] + s0[1]) + (s0[2] + s0[3]) + (s1[0] + s1[1]) + (s1[2] + s1[3])) * (1.0f / 512.0f) + EPS);
    r_fx = 1.0f / sqrtf(((s2[0] + s2[1]) + (s2[2] + s2[3]) + (s3[0] + s3[1]) + (s3[2] + s3[3])) * (1.0f / 512.0f) + EPS);
}
template <bool NORM2> struct EpiRes {
    static constexpr bool PERM = false, AFTER_DRAIN = false, MIDK = NORM2; static constexpr int MIDT = 8, MIDPM = 64;
    const float* xp; const float* ada; int gate_off; bf16_t* X1; int mode; float* partA; float* partB; const float* ssb;
    DI void mid(f32x4 (&acc)[2][2][4][2], const pg8::Unit& u, int wr, int wc, int fr, int fq) const {
        const int r0 = u.pm * 256 + wr * 64 + fq * 16 + fr;
        float s0, f0, s1, f1; row_rstd2(ssb, r0, s0, f0); row_rstd2(ssb, r0 + 128, s1, f1);
        const float q0 = s0 / f0, q1 = s1 / f1;
#pragma unroll
        for (int ai = 0; ai < 2; ++ai)
#pragma unroll
            for (int m = 0; m < 4; ++m) { const float ratio = __shfl(ai ? q1 : q0, fr + 16 * m);
#pragma unroll
                for (int bj = 0; bj < 2; ++bj)
#pragma unroll
                    for (int n = 0; n < 2; ++n) acc[ai][bj][m][n] *= ratio; }
    }
    DI void operator()(const f32x4 (&acc)[2][2][4][2], const pg8::Unit& u, int wr, int wc, int fr, int fq) const {
        const int col0 = u.pn * 256 + wc * 32 + fq * 4;
        if (u.pm >= 64) {
            const int s = u.koff / (u.nt * 64);
            float* pp = (s < 8 ? partA + (size_t)s * 1048576 : partB + (size_t)(s - 8) * 1048576) + col0;
#pragma unroll
            for (int ai = 0; ai < 2; ++ai)
#pragma unroll
                for (int m = 0; m < 4; ++m) {
                    float* po = pp + (size_t)((u.pm - 64) * 256 + ai * 128 + wr * 64 + m * 16 + fr) * 1024;
#pragma unroll
                    for (int bj = 0; bj < 2; ++bj)
#pragma unroll
                        for (int n = 0; n < 2; ++n) *(f32x4*)(po + bj * 128 + n * 16) = acc[ai][bj][m][n];
                }
            return;
        }
        const int row0 = u.pm * 256 + wr * 64 + fr;
        const float* g = ada + (size_t)(u.pm >> 5) * 6144 + gate_off + col0;
        f32x4 gp1[2][2];
#pragma unroll
        for (int bj = 0; bj < 2; ++bj)
#pragma unroll
            for (int n = 0; n < 2; ++n) gp1[bj][n] = *(const f32x4*)(g + bj * 128 + n * 16) + 1.0f;
        float rf0 = 1.0f, rf1 = 1.0f;
        if (NORM2) { float t0, t1; row_rstd2(ssb, row0 + fq * 16, t0, rf0); row_rstd2(ssb, row0 + fq * 16 + 128, t1, rf1); }
        if constexpr (NORM2) {
            f32x4 bc[2][2];
            { const float* base = xp + (size_t)row0 * 1024 + col0;
#pragma unroll
                for (int bj = 0; bj < 2; ++bj)
#pragma unroll
                    for (int n = 0; n < 2; ++n) bc[bj][n] = *(const f32x4*)(base + bj * 128 + n * 16); }
#pragma unroll
            for (int gi = 0; gi < 8; ++gi) {
                const int ai = gi >> 2, m = gi & 3;
                f32x4 bn[2][2];
                if (gi < 7) { const float* base = xp + (size_t)(row0 + ((gi + 1) >> 2) * 128 + ((gi + 1) & 3) * 16) * 1024 + col0;
#pragma unroll
                    for (int bj = 0; bj < 2; ++bj)
#pragma unroll
                        for (int n = 0; n < 2; ++n) bn[bj][n] = *(const f32x4*)(base + bj * 128 + n * 16); }
                const float rs = __shfl(ai ? rf1 : rf0, fr + 16 * m);
                bf16_t* xo = X1 + (size_t)(row0 + ai * 128 + m * 16) * 1024 + col0;
#pragma unroll
                for (int bj = 0; bj < 2; ++bj)
#pragma unroll
                    for (int n = 0; n < 2; ++n) { const f32x4 o = bc[bj][n] + gp1[bj][n] * (acc[ai][bj][m][n] * rs); u32x2 w; w.x = pk2(o[0], o[1]); w.y = pk2(o[2], o[3]); *(u32x2*)(xo + bj * 128 + n * 16) = w; }
                if (gi < 7) {
#pragma unroll
                    for (int bj = 0; bj < 2; ++bj)
#pragma unroll
                        for (int n = 0; n < 2; ++n) bc[bj][n] = bn[bj][n]; }
            }
        } else {
            u32x2 bc[2][2];
            { const bf16_t* xo = X1 + (size_t)row0 * 1024 + col0;
#pragma unroll
                for (int bj = 0; bj < 2; ++bj)
#pragma unroll
                    for (int n = 0; n < 2; ++n) bc[bj][n] = *(const u32x2*)(xo + bj * 128 + n * 16); }
#pragma unroll
            for (int gi = 0; gi < 8; ++gi) {
                const int ai = gi >> 2, m = gi & 3;
                u32x2 bn[2][2];
                if (gi < 7) { const bf16_t* xn = X1 + (size_t)(row0 + ((gi + 1) >> 2) * 128 + ((gi + 1) & 3) * 16) * 1024 + col0;
#pragma unroll
                    for (int bj = 0; bj < 2; ++bj)
#pragma unroll
                        for (int n = 0; n < 2; ++n) bn[bj][n] = *(const u32x2*)(xn + bj * 128 + n * 16); }
                bf16_t* xo = X1 + (size_t)(row0 + ai * 128 + m * 16) * 1024 + col0;
#pragma unroll
                for (int bj = 0; bj < 2; ++bj)
#pragma unroll
                    for (int n = 0; n < 2; ++n) { const u32x2 bw = bc[bj][n]; f32x4 bv; bv[0] = __uint_as_float(bw.x << 16); bv[1] = __uint_as_float(bw.x & 0xffff0000u); bv[2] = __uint_as_float(bw.y << 16); bv[3] = __uint_as_float(bw.y & 0xffff0000u);
                        const f32x4 o = bv + gp1[bj][n] * acc[ai][bj][m][n]; u32x2 w; w.x = pk2(o[0], o[1]); w.y = pk2(o[2], o[3]); *(u32x2*)(xo + bj * 128 + n * 16) = w; }
                if (gi < 7) {
#pragma unroll
                    for (int bj = 0; bj < 2; ++bj)
#pragma unroll
                        for (int n = 0; n < 2; ++n) bc[bj][n] = bn[bj][n]; }
            }
        }
    }
};
struct TailOrder {
    pg8::StaticOrder so; int S, ntk;
    DI void init(int G, int c, int K, int S_) { so.init(MP, 1024, G, c, K); S = S_; ntk = (K / 64) / S_; }
    DI bool next(int i, pg8::Unit& u) const {
        const long L = (long)i * so.G + so.c;
        if (L < so.nwg) return so.next(i, u);
        const int j = (int)(L - so.nwg); if (j >= 16 * S) return false;
        const int su = j / S, sp = j % S;
        u.pm = 64 + (su >> 2); u.pn = su & 3; u.koff = sp * ntk * 64; u.nt = ntk; return true;
    }
    DI void a_ready(const pg8::Unit&) const {}
    DI void done(const pg8::Unit&) const {}
};
struct EpiUp {
    static constexpr bool PERM = false, AFTER_DRAIN = false, MIDK = false;
    bf16_t* H;
    DI void operator()(const f32x4 (&acc)[2][2][4][2], const pg8::Unit& u, int wr, int wc, int fr, int fq) const {
#pragma unroll
        for (int ai = 0; ai < 2; ++ai)
#pragma unroll
            for (int m = 0; m < 4; ++m) {
                const int row = u.pm * 256 + ai * 128 + wr * 64 + m * 16 + fr;
                bf16_t* h = H + (size_t)row * DFF + u.pn * 128 + wc * 32 + fq * 4;
#pragma unroll
                for (int n = 0; n < 2; ++n) { const f32x4 g = acc[ai][0][m][n], up = acc[ai][1][m][n]; f32x4 v;
#pragma unroll
                    for (int e = 0; e < 4; ++e) v[e] = g[e] * __builtin_amdgcn_rcpf(1.0f + ex2(-g[e] * LOG2E)) * up[e];
                    u32x2 w; w.x = pk2(v[0], v[1]); w.y = pk2(v[2], v[3]); *(u32x2*)(h + n * 16) = w; }
            }
    }
};

constexpr int TILE_B = 64 * 144;
#define MFMA32(a, b, c) __builtin_amdgcn_mfma_f32_32x32x16_bf16((a), (b), (c), 0, 0, 0)
DI void attn_unit(LAS unsigned char* lds, const int type, const bf16_t* __restrict__ Q, const bf16_t* __restrict__ K, const bf16_t* __restrict__ V, const float* __restrict__ cK, const float* __restrict__ cV,
                  bf16_t* O, float* ss, const float* fq, const float* fk, const int qpos0, const int nq, const float kmaxn) {
    const int tid = threadIdx.x, lane = tid & 63, wid = __builtin_amdgcn_readfirstlane(tid >> 6), r32 = lane & 31, hi = lane >> 5;
    LAS unsigned char* ldsK = lds; LAS unsigned char* ldsV = lds + 2 * TILE_B; LAS float* fkt = (LAS float*)(lds + 4 * TILE_B); LAS int* flags = (LAS int*)(lds + 4 * TILE_B + 512);
    const bool wactive = wid * 32 < nq;
    const int qrow = wid * 32 + r32, qpos = qpos0 + qrow;
    bf16x8 qr[4];
#pragma unroll
    for (int d0 = 0; d0 < 4; ++d0) { qr[d0] = (bf16x8){0, 0, 0, 0, 0, 0, 0, 0}; if (wactive) qr[d0] = *(const bf16x8*)(Q + (size_t)qrow * 1024 + d0 * 16 + hi * 8); }
    float fq2 = 0.f, qn = 0.f;
    if (type == 1 && wactive) { fq2 = fq[(size_t)qrow * 8] * LOG2E;
#pragma unroll
        for (int d0 = 0; d0 < 4; ++d0)
#pragma unroll
            for (int e = 0; e < 8; ++e) { const float f = bf2f((unsigned short)qr[d0][e]); qn += f * f; }
        qn += __shfl_xor(qn, 32); qn = sqrtf(qn) * kmaxn * 1.0001f; }
    const bool bound = (type == 1) && (kmaxn < 1e30f);
    if (bound) fq2 -= qn;
    f32x16 o0, o1;
#pragma unroll
    for (int r = 0; r < 16; ++r) { o0[r] = 0.f; o1[r] = 0.f; }
    float mrun = -INFINITY, lrun = 0.f, carry = 0.f;
    bool wave_done = !wactive;
    const int kt_hi = (qpos0 + nq - 1) >> 6, wkt = (qpos0 + wid * 32 + 31) >> 6;
    const int krow_l = tid >> 3, kch = tid & 7;
    const int prow = r32;
    const int kst = (krow_l & 32) + (krow_l & 3) + 8 * ((krow_l & 15) >> 2) + 4 * ((krow_l >> 4) & 1);
    u32x4 kregs[2], vregs[2]; float fkregs[2] = {0.f, 0.f};
#define AT_GLOAD(rs_, kt_) do { u32x4 kreg, vreg; float fkreg = 0.f; if (cK != nullptr && (kt_) < 16) { \
            const float* kp_ = cK + (size_t)((kt_) * 64 + krow_l) * 512 + kch * 8; const float* vp_ = cV + (size_t)((kt_) * 64 + lane) * 512 + wid * 8; \
            const f32x4 a0_ = *(const f32x4*)kp_, a1_ = *(const f32x4*)(kp_ + 4), b0_ = *(const f32x4*)vp_, b1_ = *(const f32x4*)(vp_ + 4); \
            kreg.x = pk2(a0_[0], a0_[1]); kreg.y = pk2(a0_[2], a0_[3]); kreg.z = pk2(a1_[0], a1_[1]); kreg.w = pk2(a1_[2], a1_[3]); \
            vreg.x = pk2(b0_[0], b0_[1]); vreg.y = pk2(b0_[2], b0_[3]); vreg.z = pk2(b1_[0], b1_[1]); vreg.w = pk2(b1_[2], b1_[3]); \
        } else { const int kr_ = (cK != nullptr) ? 0 : (kt_) * 64; \
            kreg = *(const u32x4*)(K + (size_t)(kr_ + krow_l) * 1024 + kch * 8); vreg = *(const u32x4*)(V + (size_t)(kr_ + lane) * 1024 + wid * 8); } \
        if (type == 1 && tid < 64) fkreg = fk[(size_t)((kt_) * 64 + tid) * 8] * LOG2E; \
        kregs[rs_] = kreg; vregs[rs_] = vreg; fkregs[rs_] = fkreg; } while (0)
#define AT_LSTORE(rs_, buf_) do { const u32x4 kreg = kregs[rs_], vreg = vregs[rs_]; const float fkreg = fkregs[rs_]; *(LAS u32x4*)(ldsK + (buf_) * TILE_B + kst * 144 + kch * 16) = kreg; \
        LAS unsigned short* vd_ = (LAS unsigned short*)(ldsV + (buf_) * TILE_B + (wid * 8) * 144 + lane * 2); \
        vd_[0] = (unsigned short)(vreg.x & 0xffffu); vd_[72] = (unsigned short)(vreg.x >> 16); vd_[144] = (unsigned short)(vreg.y & 0xffffu); vd_[216] = (unsigned short)(vreg.y >> 16); \
        vd_[288] = (unsigned short)(vreg.z & 0xffffu); vd_[360] = (unsigned short)(vreg.z >> 16); vd_[432] = (unsigned short)(vreg.w & 0xffffu); vd_[504] = (unsigned short)(vreg.w >> 16); \
        if (type == 1 && tid < 64) fkt[(buf_) * 64 + tid] = fkreg; } while (0)
    AT_GLOAD(0, kt_hi); AT_LSTORE(0, 0); __syncthreads();
    if (kt_hi >= 1) AT_GLOAD(1, kt_hi - 1);
    int kt = kt_hi;
    for (;;) {
#pragma unroll
      for (int buf = 0; buf < 2; ++buf) {
        if (kt >= 2) AT_GLOAD(buf, kt - 2);
        if (!wave_done && kt <= wkt) {
            const LAS unsigned char* Kb = ldsK + buf * TILE_B; const LAS unsigned char* Vb = ldsV + buf * TILE_B;
            f32x16 s0, s1;
            { const float ci = type == 1 ? fq2 : 0.f;
#pragma unroll
                for (int r = 0; r < 16; ++r) { s0[r] = ci; s1[r] = ci; } }
            {   bf16x8 ka[4], kb[4];
#pragma unroll
                for (int d0 = 0; d0 < 4; ++d0) { ka[d0] = *(const LAS bf16x8*)(Kb + prow * 144 + (d0 * 16 + hi * 8) * 2); kb[d0] = *(const LAS bf16x8*)(Kb + (32 + prow) * 144 + (d0 * 16 + hi * 8) * 2); }
                __builtin_amdgcn_s_setprio(1);
#pragma unroll
                for (int d0 = 0; d0 < 4; ++d0) { s0 = MFMA32(ka[d0], qr[d0], s0); s1 = MFMA32(kb[d0], qr[d0], s1); }
                __builtin_amdgcn_s_setprio(0);
            }
            const int kvb = kt * 64 + 16 * hi;
            if (type == 1) {
                const LAS f32x4* fk4 = (const LAS f32x4*)(fkt + buf * 64 + 16 * hi);
#pragma unroll
                for (int g = 0; g < 4; ++g) { const f32x4 a = fk4[g], b = fk4[8 + g];
#pragma unroll
                    for (int e = 0; e < 4; ++e) { s0[4 * g + e] -= a[e]; s1[4 * g + e] -= b[e]; } }
                if (kt * 64 + 63 > qpos0 + wid * 32) {
#pragma unroll
                    for (int r = 0; r < 16; ++r) { if (kvb + r > qpos) s0[r] = -INFINITY; if (kvb + 32 + r > qpos) s1[r] = -INFINITY; }
                }
                if (bound) {
                    if (kt == wkt) { float mx = __builtin_fmaxf(s0[0], s1[0]);
#pragma unroll
                        for (int r = 1; r < 16; ++r) mx = __builtin_fmaxf(mx, __builtin_fmaxf(s0[r], s1[r]));
                        mrun = __builtin_fmaxf(mx, __shfl_xor(mx, 32)); }
                    float ps = 0.f;
#pragma unroll
                    for (int r = 0; r < 16; ++r) { s0[r] = ex2(s0[r]); s1[r] = ex2(s1[r]); ps += s0[r] + s1[r]; }
                    lrun += ps;
                } else {
                    float mx = __builtin_fmaxf(s0[0], s1[0]);
#pragma unroll
                    for (int r = 1; r < 16; ++r) mx = __builtin_fmaxf(mx, __builtin_fmaxf(s0[r], s1[r]));
                    mx = __builtin_fmaxf(mx, __shfl_xor(mx, 32));
                    const float mnew = __builtin_fmaxf(mrun, mx), alpha = ex2(mrun - mnew); mrun = mnew;
                    float ps = 0.f;
#pragma unroll
                    for (int r = 0; r < 16; ++r) { s0[r] = ex2(s0[r] - mnew); s1[r] = ex2(s1[r] - mnew); ps += s0[r] + s1[r]; }
                    lrun = lrun * alpha + ps;
                    if (__any(alpha != 1.0f)) {
#pragma unroll
                        for (int r = 0; r < 16; ++r) { o0[r] *= alpha; o1[r] *= alpha; } }
                }
            } else {
                f32x16 l0, l1; float T0 = 0.f, T1 = 0.f;
#pragma unroll
                for (int r = 0; r < 16; ++r) {
                    const float t0 = s0[r], t1 = s1[r];
                    float k0 = -(fmaxf(t0, 0.f) + lg2(1.0f + ex2(-fabsf(t0)))), k1 = -(fmaxf(t1, 0.f) + lg2(1.0f + ex2(-fabsf(t1))));
                    if (!(kvb + r < qpos)) k0 = 0.f;
                    if (!(kvb + 32 + r < qpos)) k1 = 0.f;
                    l0[r] = k0; l1[r] = k1; T0 += k0; T1 += k1;
                }
                const float U0 = __shfl_xor(T0, 32), U1 = __shfl_xor(T1, 32);
                float run = carry + (hi ? 0.f : U1);
#pragma unroll
                for (int r = 15; r >= 0; --r) { run += l1[r]; float a = ex2(s1[r] + run); if (!(kvb + 32 + r < qpos)) a = 0.f; s1[r] = a; }
                run = carry + (hi ? (T1 + U1) : (U1 + T1 + U0));
#pragma unroll
                for (int r = 15; r >= 0; --r) { run += l0[r]; float a = ex2(s0[r] + run); if (!(kvb + r < qpos)) a = 0.f; s0[r] = a; }
                carry += (T0 + T1) + (U0 + U1);
            }
#pragma unroll
            for (int c = 0; c < 4; ++c) {
                u32x4 pw;
                if (c == 0)      { pw.x = pk2(s0[0], s0[1]); pw.y = pk2(s0[2], s0[3]); pw.z = pk2(s0[4], s0[5]); pw.w = pk2(s0[6], s0[7]); }
                else if (c == 1) { pw.x = pk2(s0[8], s0[9]); pw.y = pk2(s0[10], s0[11]); pw.z = pk2(s0[12], s0[13]); pw.w = pk2(s0[14], s0[15]); }
                else if (c == 2) { pw.x = pk2(s1[0], s1[1]); pw.y = pk2(s1[2], s1[3]); pw.z = pk2(s1[4], s1[5]); pw.w = pk2(s1[6], s1[7]); }
                else             { pw.x = pk2(s1[8], s1[9]); pw.y = pk2(s1[10], s1[11]); pw.z = pk2(s1[12], s1[13]); pw.w = pk2(s1[14], s1[15]); }
                const bf16x8 pf = __builtin_bit_cast(bf16x8, pw);
                const int kvoff = 32 * (c >> 1) + 16 * hi + 8 * (c & 1);
                const bf16x8 va = *(const LAS bf16x8*)(Vb + r32 * 144 + kvoff * 2);
                const bf16x8 vb = *(const LAS bf16x8*)(Vb + (32 + r32) * 144 + kvoff * 2);
                o0 = MFMA32(va, pf, o0); o1 = MFMA32(vb, pf, o1);
            }
            if (type == 0) wave_done = __all(carry < -40.0f);
            else wave_done = __all((bound ? 0.f : qn) + fq2 - fkt[buf * 64] - mrun < -40.0f);
        }
        if (lane == 0) flags[buf * 8 + wid] = wave_done ? 1 : 0;
        if (kt >= 1) AT_LSTORE(buf ^ 1, buf ^ 1);
        __syncthreads();
        { int alld = 1;
#pragma unroll
            for (int w = 0; w < 8; ++w) alld &= flags[buf * 8 + w];
            if (alld) goto at_done; }
        if (--kt < 0) goto at_done;
      }
    }
at_done:
#undef AT_GLOAD
#undef AT_LSTORE
    if (wactive) {
        if (type == 1) { const float lt = lrun + __shfl_xor(lrun, 32); const float inv = 1.0f / lt;
#pragma unroll
            for (int r = 0; r < 16; ++r) { o0[r] *= inv; o1[r] *= inv; } }
        float sq = 0.f;
#pragma unroll
        for (int r = 0; r < 16; ++r) sq += o0[r] * o0[r] + o1[r] * o1[r];
        sq += __shfl_xor(sq, 32);
        if (hi == 0) ss[(size_t)qrow * 16] = sq;
        bf16_t* orow = O + (size_t)qrow * 1024 + 4 * hi;
#pragma unroll
        for (int g = 0; g < 4; ++g) {
            u32x2 w0, w1; w0.x = pk2(o0[4 * g], o0[4 * g + 1]); w0.y = pk2(o0[4 * g + 2], o0[4 * g + 3]); w1.x = pk2(o1[4 * g], o1[4 * g + 1]); w1.y = pk2(o1[4 * g + 2], o1[4 * g + 3]);
            *(u32x2*)(orow + 8 * g) = w0; *(u32x2*)(orow + 32 + 8 * g) = w1;
        }
    }
}

DI void transpose_item(const float* W, int K, int N, bf16_t* WT, int dst_row, int k0, int n0, LAS float* scr, int lane, const float* gk = nullptr, bool has_g = false) {
    float tv[32];
#pragma unroll
    for (int i = 0; i < 32; ++i) tv[i] = W[(size_t)(k0 + 2 * i + (lane >> 5)) * N + n0 + (lane & 31)];
    if (has_g) {
#pragma unroll
        for (int i = 0; i < 32; ++i) tv[i] *= gk[2 * i + (lane >> 5)]; }
#pragma unroll
    for (int i = 0; i < 32; ++i) scr[(2 * i + (lane >> 5)) * 33 + (lane & 31)] = tv[i];
    asm volatile("s_waitcnt lgkmcnt(0)" ::: "memory");
    const int c = lane & 7;
#pragma unroll
    for (int j = 0; j < 4; ++j) { const int n = (lane >> 3) + 8 * j; const LAS float* s = scr + (8 * c) * 33 + n;
        u32x4 o; o.x = pk2(s[0 * 33], s[1 * 33]); o.y = pk2(s[2 * 33], s[3 * 33]); o.z = pk2(s[4 * 33], s[5 * 33]); o.w = pk2(s[6 * 33], s[7 * 33]);
        *(u32x4*)(WT + (size_t)(dst_row + n) * K + k0 + 8 * c) = o; }
    asm volatile("s_waitcnt lgkmcnt(0)" ::: "memory");
}
DI void load_row(f32x4 (&v)[4], const float* x, int lane) {
    const f32x4* xr = (const f32x4*)x + lane;
#pragma unroll
    for (int j = 0; j < 4; ++j) v[j] = xr[64 * j];
}
DI void load_row_bf16(f32x4 (&v)[4], const bf16_t* x, int lane) {
#pragma unroll
    for (int j = 0; j < 4; ++j) { const u32x2 w = *(const u32x2*)(x + 4 * lane + 256 * j); v[j][0] = __uint_as_float(w.x << 16); v[j][1] = __uint_as_float(w.x & 0xffff0000u); v[j][2] = __uint_as_float(w.y << 16); v[j][3] = __uint_as_float(w.y & 0xffff0000u); }
}
DI void load_raw_bf16(u32x2 (&w)[4], const bf16_t* x, int lane) {
#pragma unroll
    for (int j = 0; j < 4; ++j) w[j] = *(const u32x2*)(x + 4 * lane + 256 * j);
}
DI void cvt_raw_bf16(f32x4 (&v)[4], const u32x2 (&w)[4]) {
#pragma unroll
    for (int j = 0; j < 4; ++j) { v[j][0] = __uint_as_float(w[j].x << 16); v[j][1] = __uint_as_float(w[j].x & 0xffff0000u); v[j][2] = __uint_as_float(w[j].y << 16); v[j][3] = __uint_as_float(w[j].y & 0xffff0000u); }
}
DI void add_parts(f32x4 (&v)[4], const float* pA, const float* pB, int S, int srow, const float* gate, int lane) {
#pragma unroll
    for (int j = 0; j < 4; ++j) { const int c = 4 * lane + 256 * j; f32x4 sum = {0.f, 0.f, 0.f, 0.f};
        for (int sp = 0; sp < S; ++sp) sum += *(const f32x4*)((sp < 8 ? pA + (size_t)sp * 1048576 : pB + (size_t)(sp - 8) * 1048576) + (size_t)srow * 1024 + c);
        v[j] += (*(const f32x4*)(gate + c) + 1.0f) * sum; }
}
DI void add_parts6(f32x4 (&v)[4], const float* pA, int srow, const float* gate, float r_sb, float r_fx, int lane) {
#pragma unroll
    for (int j = 0; j < 4; ++j) { const int c = 4 * lane + 256 * j; f32x4 sa = {0.f, 0.f, 0.f, 0.f}, sb = {0.f, 0.f, 0.f, 0.f};
#pragma unroll
        for (int sp = 0; sp < 4; ++sp) { sa += *(const f32x4*)(pA + (size_t)sp * 1048576 + (size_t)srow * 1024 + c); sb += *(const f32x4*)(pA + (size_t)(sp + 4) * 1048576 + (size_t)srow * 1024 + c); }
        v[j] += (*(const f32x4*)(gate + c) + 1.0f) * (sa * r_sb + sb * r_fx); }
}
DI float row_rstd(const f32x4 (&v)[4]) {
    float s = 0.f;
#pragma unroll
    for (int j = 0; j < 4; ++j) s += (v[j][0] * v[j][0] + v[j][1] * v[j][1]) + (v[j][2] * v[j][2] + v[j][3] * v[j][3]);
    return 1.0f / sqrtf(wave_sum(s) * (1.0f / 1024.0f) + EPS);
}
DI void norm_store_bf16(const f32x4 (&v)[4], const float* g, const float* scale, const float* shift, bf16_t* o, int lane) {
    const float rstd = row_rstd(v);
#pragma unroll
    for (int j = 0; j < 4; ++j) { const int c = 4 * lane + 256 * j; const f32x4 gv = *(const f32x4*)(g + c), sc = *(const f32x4*)(scale + c), sh = *(const f32x4*)(shift + c);
        const f32x4 r = (v[j] * rstd * gv) * (sc + 1.0f) + sh; u32x2 w; w.x = pk2(r[0], r[1]); w.y = pk2(r[2], r[3]); *(u32x2*)(o + c) = w; }
}
DI void norm_store_f32(const f32x4 (&v)[4], const float* g, float* o, int lane) {
    const float rstd = row_rstd(v);
#pragma unroll
    for (int j = 0; j < 4; ++j) { const int c = 4 * lane + 256 * j; const f32x4 gv = *(const f32x4*)(g + c); *(f32x4*)(o + c) = v[j] * rstd * gv; }
}

struct Args { const float* in[22]; float* out; unsigned char* ws; int ph_lo, ph_hi; };
enum { I_XP = 0, I_XS, I_CP, I_CS, I_CSBK, I_CSBV, I_CFXK, I_CFXV, I_CLF, I_WADA, I_BADA, I_GMIX, I_WIN, I_BF, I_GSB, I_GFX, I_WO, I_GFFN, I_WG, I_WU, I_WD, I_GFIN };
constexpr int NPHASE = 11;

__global__ void __launch_bounds__(512, 2) mk_fwd(Args a) {
    extern __shared__ __attribute__((aligned(16))) unsigned char lds_raw[];
    LAS unsigned char* lds = (LAS unsigned char*)lds_raw;
    cg::grid_group grid = cg::this_grid();
    const int tid = threadIdx.x, lane = tid & 63, wave = __builtin_amdgcn_readfirstlane(tid >> 6);
    const int G = gridDim.x, bid = blockIdx.x;
    const int gw = bid * 8 + wave, NGW = G * 8;
    unsigned char* ws = a.ws; float* out = a.out;
    float* ada = (float*)(ws + WS_ADA); float* fcp = (float*)(ws + WS_FCP); float* fcs = (float*)(ws + WS_FCS); float* ssb = (float*)(ws + WS_SS);
    bf16_t* WinT = (bf16_t*)(ws + WS_WIN); bf16_t* WoT = (bf16_t*)(ws + WS_WO); bf16_t* WguT = (bf16_t*)(ws + WS_WGU); bf16_t* WdT = (bf16_t*)(ws + WS_WD);
    bf16_t* Hn = (bf16_t*)(ws + WS_HN); bf16_t* Qb = (bf16_t*)(ws + WS_QB); bf16_t* Kp = (bf16_t*)(ws + WS_KP); bf16_t* Vp = (bf16_t*)(ws + WS_VP);
    bf16_t* Ks = (bf16_t*)(ws + WS_KS); bf16_t* Vs = (bf16_t*)(ws + WS_VS); bf16_t* Hff = (bf16_t*)(ws + WS_HFF); bf16_t* X1 = (bf16_t*)(ws + WS_X1);
    unsigned* kmax2 = (unsigned*)(ws + WS_KMAX); unsigned* uctr = (unsigned*)(ws + WS_CTR);
    float* part6 = (float*)(ws + 100 * MiB);
    float* part9a = (float*)(ws + WS_HN); float* part9b = (float*)(ws + 160 * MiB);
    const int lo = a.ph_lo, hi_ph = a.ph_hi;
#define IN(k) (lo <= (k) && (k) < hi_ph)
#ifndef REP_SYNC
#define REP_SYNC 1
#endif
#define SEAM(k) do { if (IN(k) && IN((k) + 1)) { for (int rs_ = 0; rs_ < REP_SYNC; ++rs_) xcd_barrier(xbar); } } while (0)
    LAS unsigned* misc = (LAS unsigned*)(lds + 131072);
    if (tid < 16) misc[tid] = 0u;
    __syncthreads();
    XcdBarrier xbar = xcd_barrier_post((unsigned*)(ws + WS_BAR), (volatile LAS unsigned*)(misc + 8));
    if (lo < 0) grid.sync();

    if (IN(0)) {
        for (int cb = bid; cb < 192; cb += G) {
            LAS float* sil = (LAS float*)lds;
            LAS float* red = (LAS float*)(lds + 73728);
            for (int i = tid; i < 18 * 1024; i += 512) { const int b = i >> 10, k = i & 1023; const float c = b < 2 ? a.in[I_CP][b * 1024 + k] : a.in[I_CS][(b - 2) * 1024 + k]; sil[i] = c / (1.0f + expf(-c)); }
            __syncthreads();
            const int kg = tid >> 3, c4 = tid & 7, col0 = cb * 32;
            f32x4 acc[18];
#pragma unroll
            for (int b = 0; b < 18; ++b) acc[b] = (f32x4){0.f, 0.f, 0.f, 0.f};
            const float* wp = a.in[I_WADA] + (size_t)kg * 6144 + col0 + 4 * c4;
#pragma unroll 2
            for (int i = 0; i < 16; ++i) { const f32x4 w4 = *(const f32x4*)(wp + (size_t)i * 64 * 6144); const int k = kg + 64 * i;
#pragma unroll
                for (int b = 0; b < 18; ++b) acc[b] += w4 * sil[b * 1024 + k]; }
#pragma unroll
            for (int b = 0; b < 18; ++b)
#pragma unroll
                for (int e = 0; e < 4; ++e) { float v = acc[b][e]; v += __shfl_xor(v, 8); v += __shfl_xor(v, 16); v += __shfl_xor(v, 32); acc[b][e] = v; }
            if (lane < 8) {
#pragma unroll
                for (int b = 0; b < 18; ++b) *(LAS f32x4*)(red + ((wave * 8 + lane) * 18 + b) * 4) = acc[b]; }
            __syncthreads();
            for (int o = tid; o < 18 * 32; o += 512) { const int b = o >> 5, c = o & 31; float sum = a.in[I_BADA][col0 + c];
#pragma unroll
                for (int w = 0; w < 8; ++w) sum += red[((w * 8 + (c >> 2)) * 18 + b) * 4 + (c & 3)];
                ada[(size_t)b * 6144 + col0 + c] = sum; }
            __syncthreads();
        }
        {
            LAS float* scr = (LAS float*)(lds + 8192 + wave * 8448);
            for (int it = gw; it < 16 * 96; it += NGW) { const int kb = it / 96, nb = it % 96; transpose_item(a.in[I_WIN], 1024, NIN, WinT, nb * 32, kb * 64, nb * 32, scr, lane); }
            for (int i = bid * 512 + tid; i < 8 * 1024; i += G * 512) { const int j = i >> 10, k = i & 1023; const float w = a.in[I_WIN][(size_t)k * NIN + 3072 + j];
                WinT[(size_t)(3072 + j) * 1024 + k] = (bf16_t)(pk2(w, 0.f) & 0xffffu); }
        }
    }
    SEAM(0);
    if (IN(1)) {
        int ln = lane; asm volatile("" : "+v"(ln));
        {
            f32x4 S0[4], S1[4], S2[4], S3[4]; int r = gw;
#define P1_LD(S, k) load_row(S, a.in[I_XP] + (size_t)min(r + (k) * NGW, MP - 1) * 1024, ln)
#define P1_DO(S, k) do { const int row = min(r + (k) * NGW, MP - 1); const float* ad = ada + (size_t)(row >> 13) * 6144; norm_store_bf16(S, a.in[I_GMIX], ad + 1024, ad, Hn + (size_t)row * 1024, ln); } while (0)
            P1_LD(S0, 0); P1_LD(S1, 1); P1_LD(S2, 2); P1_LD(S3, 3);
            for (; r < MP; r += 4 * NGW) { P1_DO(S0, 0); P1_LD(S0, 4); P1_DO(S1, 1); P1_LD(S1, 5); P1_DO(S2, 2); P1_LD(S2, 6); P1_DO(S3, 3); P1_LD(S3, 7); }
#undef P1_LD
#undef P1_DO
        }
        for (int row = MP + gw; row < M; row += NGW) { const float* ad = ada + (size_t)row_batch(row) * 6144;
            f32x4 v[4]; load_row(v, a.in[I_XS] + (size_t)(row - MP) * 1024, ln); norm_store_bf16(v, a.in[I_GMIX], ad + 1024, ad, Hn + (size_t)row * 1024, ln); }
    }
    SEAM(1);
    if (IN(2)) {
        pg8::Gemm g{Hn, WinT, M, NINP, 1024}; pg8::StaticOrder S; S.init(M, NINP, G, bid, 1024);
        EpiIn E{out, Qb, ws, a.in[I_BF]};
        pg8::gemm_phase<EpiIn, pg8::StaticOrder, true, true>(lds, g, S, E);
        {
            const int rem = S.nwg % G, nidle = rem ? G - rem : G, iw = rem ? bid - rem : bid;
            if (iw >= 0) {
                __syncthreads();
                LAS float* scr = (LAS float*)(lds + wave * 8448);
                constexpr int I_O = 16 * 32, I_G = 16 * 88, I_D = 44 * 32, NIT = I_O + 2 * I_G + I_D;
                for (int it = iw * 8 + wave; it < NIT; it += nidle * 8) {
                    int r = it;
                    if (r < I_O) { const int kb = r / 32, nb = r % 32; transpose_item(a.in[I_WO], 1024, 1024, WoT, nb * 32, kb * 64, nb * 32, scr, lane, kb < 8 ? a.in[I_GSB] + kb * 64 : a.in[I_GFX] + (kb - 8) * 64, true); continue; } r -= I_O;
                    if (r < I_G) { const int kb = r / 88, nb = r % 88, n0 = nb * 32; transpose_item(a.in[I_WG], 1024, DFF, WguT, 256 * (n0 >> 7) + (n0 & 127), kb * 64, n0, scr, lane); continue; } r -= I_G;
                    if (r < I_G) { const int kb = r / 88, nb = r % 88, n0 = nb * 32; transpose_item(a.in[I_WU], 1024, DFF, WguT, 256 * (n0 >> 7) + 128 + (n0 & 127), kb * 64, n0, scr, lane); continue; } r -= I_G;
                    { const int kb = r / 32, nb = r % 32; transpose_item(a.in[I_WD], DFF, 1024, WdT, nb * 32, kb * 64, nb * 32, scr, lane); }
                }
            }
        }
    }
    SEAM(2);
    if (IN(3)) {
        LAS float* sm = (LAS float*)lds; LAS float* sm2 = sm + 128;
        for (int job = bid; job < 144 + 256; job += G) {
            if (job < 144) {
                const bool pr = job < 64; int b, c; if (pr) { b = job >> 5; c = job & 31; } else { const int j = job - 64; b = j / 5; c = j - 5 * b; }
                const float* srcA = pr ? out + O_LFP + (size_t)b * TP * 8 : a.in[I_CLF] + (size_t)b * 1024 * 8;
                f32x4 ps = {0.f, 0.f, 0.f, 0.f};
                const f32x4* s4 = (const f32x4*)srcA;
                for (int i0 = 0; i0 < c; i0 += 8) {
                    f32x4 t[8];
#pragma unroll
                    for (int j = 0; j < 8; ++j) { t[j] = (f32x4){0.f, 0.f, 0.f, 0.f}; if (i0 + j < c) t[j] = s4[tid + 512 * (i0 + j)]; }
                    ps += ((t[0] + t[1]) + (t[2] + t[3])) + ((t[4] + t[5]) + (t[6] + t[7])); }
#pragma unroll
                for (int off = 2; off < 64; off <<= 1) { ps[0] += __shfl_xor(ps[0], off); ps[1] += __shfl_xor(ps[1], off); ps[2] += __shfl_xor(ps[2], off); ps[3] += __shfl_xor(ps[3], off); }
                if (lane < 2) *(LAS f32x4*)(sm + (wave * 2 + lane) * 4) = ps;
                const int nrows = (pr || c < 4) ? 256 : 64;
                float v[8];
#pragma unroll
                for (int e = 0; e < 8; ++e) v[e] = 0.f;
                if (tid < nrows) { const float* rp = (pr || c < 4) ? srcA + (size_t)(256 * c + tid) * 8 : out + O_LFS + ((size_t)b * 64 + tid) * 8;
                    const f32x4 v0 = *(const f32x4*)rp, v1 = *(const f32x4*)(rp + 4); v[0] = v0[0]; v[1] = v0[1]; v[2] = v0[2]; v[3] = v0[3]; v[4] = v1[0]; v[5] = v1[1]; v[6] = v1[2]; v[7] = v1[3]; }
#pragma unroll
                for (int off = 1; off < 64; off <<= 1) {
#pragma unroll
                    for (int e = 0; e < 8; ++e) { const float n = __shfl_up(v[e], off); if (lane >= off) v[e] += n; } }
                if (lane == 63) {
#pragma unroll
                    for (int e = 0; e < 8; ++e) sm2[wave * 8 + e] = v[e]; }
                __syncthreads();
#pragma unroll
                for (int e = 0; e < 8; ++e) { float p = 0.f;
#pragma unroll
                    for (int w = 0; w < 8; ++w) p += sm[(w * 2 + (e >> 2)) * 4 + (e & 3)];
                    for (int w = 0; w < wave; ++w) p += sm2[w * 8 + e];
                    v[e] += p; }
                if (tid < nrows) { float* dp = (pr ? fcp + ((size_t)b * TP + 256 * c + tid) * 8 : fcs + ((size_t)b * TS + 256 * c + tid) * 8);
                    *(f32x4*)dp = (f32x4){v[0], v[1], v[2], v[3]}; *(f32x4*)(dp + 4) = (f32x4){v[4], v[5], v[6], v[7]}; }
                __syncthreads();
            } else {
                const int jb = job - 144, row = jb * 64 + (tid >> 3), h = tid & 7;
                const u32x4* kp = (const u32x4*)(Kp + (size_t)row * 1024 + 512 + h * 64);
                float sq = 0.f;
#pragma unroll
                for (int i = 0; i < 8; ++i) { const u32x4 w = kp[i];
                    const float f0 = __uint_as_float(w.x << 16), f1 = __uint_as_float(w.x & 0xffff0000u), f2 = __uint_as_float(w.y << 16), f3 = __uint_as_float(w.y & 0xffff0000u);
                    const float f4 = __uint_as_float(w.z << 16), f5 = __uint_as_float(w.z & 0xffff0000u), f6 = __uint_as_float(w.w << 16), f7 = __uint_as_float(w.w & 0xffff0000u);
                    sq += (f0 * f0 + f1 * f1) + (f2 * f2 + f3 * f3) + (f4 * f4 + f5 * f5) + (f6 * f6 + f7 * f7); }
                sq = fmaxf(sq, __shfl_xor(sq, 8)); sq = fmaxf(sq, __shfl_xor(sq, 16)); sq = fmaxf(sq, __shfl_xor(sq, 32));
                if (lane < 8) atomicMax(kmax2 + (row >> 13) * 8 + lane, __float_as_uint(sq));
            }
        }
    }
    SEAM(3);
    if (IN(4)) for (int rep = 0; rep < REP_ATT; ++rep) {
        if (rep) { xcd_barrier(xbar); if (bid == 0 && tid == 0) __hip_atomic_store(uctr, 0u, __ATOMIC_RELAXED, __HIP_MEMORY_SCOPE_AGENT); xcd_barrier(xbar); }
        LAS int* uslot = (LAS int*)(lds + 4 * TILE_B + 1024);
        for (int first = 1;; first = 0) {
            int u = bid;
            if (!first) {
                if (tid == 0) *uslot = (int)atomicAdd(uctr, 1u) + G;
                __syncthreads();
                u = __builtin_amdgcn_readfirstlane(*uslot);
                __syncthreads();
            }
            if (u >= 1280) break;
            int type, b, h, qb = 0; bool samp = false;
            if (u < 512) { type = 1; qb = 31 - (u >> 4); b = (u >> 3) & 1; h = u & 7; }
            else if (u < 640) { const int w = u - 512; samp = true; type = 1; b = w >> 3; h = w & 7; }
            else if (u < 1152) { const int w = u - 640; type = 0; qb = 31 - (w >> 4); b = (w >> 3) & 1; h = w & 7; }
            else { const int w = u - 1152; samp = true; type = 0; b = w >> 3; h = w & 7; }
            const int colo = type * 512 + h * 64;
            const size_t rb = (size_t)b * TP, q0 = samp ? (size_t)MP + (size_t)b * 64 : rb + (size_t)qb * 256, kb = (size_t)b * TS;
            const bf16_t* Kb_ = samp ? Ks + (size_t)b * 64 * 1024 + colo : Kp + rb * 1024 + colo;
            const bf16_t* Vb_ = samp ? Vs + (size_t)b * 64 * 1024 + colo : Vp + rb * 1024 + colo;
            const float* cK = nullptr; const float* cV = nullptr;
            if (samp) { cK = (type ? a.in[I_CFXK] : a.in[I_CSBK]) + (size_t)b * 1024 * 512 + h * 64; cV = (type ? a.in[I_CFXV] : a.in[I_CSBV]) + (size_t)b * 1024 * 512 + h * 64; }
            const float kmn = (!samp && type == 1) ? sqrtf(__uint_as_float(kmax2[b * 8 + h])) : INFINITY;
            const float* fqp = samp ? fcs + (kb + 1024) * 8 + h : fcp + q0 * 8 + h; const float* fkp = samp ? fcs + kb * 8 + h : fcp + rb * 8 + h;
            attn_unit(lds, type, Qb + q0 * 1024 + colo, Kb_, Vb_, cK, cV, Hn + q0 * 1024 + colo, ssb + q0 * 16 + type * 8 + h, fqp, fkp, samp ? 1024 : qb * 256, samp ? 64 : 256, kmn);
        }
    }
    SEAM(4);
    if (IN(6)) {
        pg8::Gemm g{Hn, WoT, M, 1024, 1024}; TailOrder S; S.init(G, bid, 1024, 8);
        EpiRes<true> E{a.in[I_XP], ada, 2048, X1, 0, part6, part6, ssb};
        pg8::gemm_phase<EpiRes<true>, TailOrder, true, true>(lds, g, S, E);
    }
    SEAM(6);
    if (IN(7)) {
        int ln = lane; asm volatile("" : "+v"(ln));
        {
            u32x2 S0[4], S1[4], S2[4], S3[4]; int r = gw;
#define P7_LD(S, k) load_raw_bf16(S, X1 + (size_t)min(r + (k) * NGW, MP - 1) * 1024, ln)
#define P7_DO(S, k) do { const int row = min(r + (k) * NGW, MP - 1); const float* ad = ada + (size_t)(row >> 13) * 6144; f32x4 v[4]; cvt_raw_bf16(v, S); norm_store_bf16(v, a.in[I_GFFN], ad + 4096, ad + 3072, Hn + (size_t)row * 1024, ln); } while (0)
            P7_LD(S0, 0); P7_LD(S1, 1); P7_LD(S2, 2); P7_LD(S3, 3);
            for (; r < MP; r += 4 * NGW) { P7_DO(S0, 0); P7_LD(S0, 4); P7_DO(S1, 1); P7_LD(S1, 5); P7_DO(S2, 2); P7_LD(S2, 6); P7_DO(S3, 3); P7_LD(S3, 7); }
#undef P7_LD
#undef P7_DO
        }
        for (int row = MP + gw; row < M; row += NGW) { const float* ad = ada + (size_t)row_batch(row) * 6144;
            f32x4 v[4]; load_row(v, a.in[I_XS] + (size_t)(row - MP) * 1024, ln); float r_sb, r_fx; row_rstd2(ssb, row, r_sb, r_fx); add_parts6(v, part6, row - MP, ad + 2048, r_sb, r_fx, ln);
#pragma unroll
            for (int j = 0; j < 4; ++j) { u32x2 w; w.x = pk2(v[j][0], v[j][1]); w.y = pk2(v[j][2], v[j][3]); *(u32x2*)(X1 + (size_t)row * 1024 + 4 * ln + 256 * j) = w; }
            norm_store_bf16(v, a.in[I_GFFN], ad + 4096, ad + 3072, Hn + (size_t)row * 1024, ln); }
    }
    SEAM(7);
    if (IN(8)) {
        pg8::Gemm g{Hn, WguT, M, 2 * DFF, 1024}; pg8::StaticOrder S; S.init(M, 2 * DFF, G, bid, 1024);
        EpiUp E{Hff};
        pg8::gemm_phase<EpiUp, pg8::StaticOrder, true, true>(lds, g, S, E);
    }
    SEAM(8);
    if (IN(9)) {
        pg8::Gemm g{Hff, WdT, M, 1024, DFF}; TailOrder S; S.init(G, bid, DFF, 11);
        EpiRes<false> E{a.in[I_XP], ada, 5120, X1, 1, part9a, part9b, ssb};
        pg8::gemm_phase<EpiRes<false>, TailOrder, true, true>(lds, g, S, E);
    }
    SEAM(9);
    if (IN(10)) {
        int ln = lane; asm volatile("" : "+v"(ln));
        {
            u32x2 S0[4], S1[4], S2[4], S3[4]; int r = gw;
#define P10_LD(S, k) load_raw_bf16(S, X1 + (size_t)min(r + (k) * NGW, MP - 1) * 1024, ln)
#define P10_DO(S, k) do { const int row = min(r + (k) * NGW, MP - 1); f32x4 v[4]; cvt_raw_bf16(v, S); norm_store_f32(v, a.in[I_GFIN], out + O_YP + (size_t)row * 1024, ln); } while (0)
            P10_LD(S0, 0); P10_LD(S1, 1); P10_LD(S2, 2); P10_LD(S3, 3);
            for (; r < MP; r += 4 * NGW) { P10_DO(S0, 0); P10_LD(S0, 4); P10_DO(S1, 1); P10_LD(S1, 5); P10_DO(S2, 2); P10_LD(S2, 6); P10_DO(S3, 3); P10_LD(S3, 7); }
#undef P10_LD
#undef P10_DO
        }
        for (int row = MP + gw; row < M; row += NGW) { f32x4 v[4]; load_row_bf16(v, X1 + (size_t)row * 1024, ln);
            add_parts(v, part9a, part9b, 11, row - MP, ada + (size_t)row_batch(row) * 6144 + 5120, ln);
            norm_store_f32(v, a.in[I_GFIN], out + O_YS + (size_t)(row - MP) * 1024, ln); }
    }
#undef IN
#undef SEAM
}
}

extern "C" void kernel_launch(void* const* d_in, const int* in_sizes, int n_in, void* d_out, int out_size, void* d_ws, size_t ws_size, hipStream_t stream) {
    using namespace mk;
    static int grid = 0;
    if (grid == 0) {
        int dev = 0, cus = 0, per_cu = 0;
        (void)hipGetDevice(&dev); (void)hipDeviceGetAttribute(&cus, hipDeviceAttributeMultiprocessorCount, dev);
        if (hipFuncSetAttribute((const void*)mk_fwd, hipFuncAttributeMaxDynamicSharedMemorySize, LDS_BYTES) != hipSuccess) { fprintf(stderr, "kernel_launch: hipFuncSetAttribute failed\n"); grid = -1; return; }
        if (hipOccupancyMaxActiveBlocksPerMultiprocessor(&per_cu, (const void*)mk_fwd, 512, LDS_BYTES) != hipSuccess || per_cu < 1) { fprintf(stderr, "kernel_launch: occupancy query gave %d\n", per_cu); per_cu = 1; }
        (void)hipGetLastError();
        grid = cus * 1;
        if (grid <= 0) grid = 256;
    }
    if (grid < 0) return;
    (void)hipMemsetAsync((char*)d_ws + WS_BAR, 0, CTL_BYTES - WS_BAR, stream);
    Args a{};
    for (int i = 0; i < 22; ++i) a.in[i] = (const float*)d_in[i];
    a.out = (float*)d_out; a.ws = (unsigned char*)d_ws;
#if MK_MULTI
    for (int p = 0; p < NPHASE; ++p) { a.ph_lo = p; a.ph_hi = p + 1; hipLaunchKernelGGL(mk_fwd, dim3(grid), dim3(512), LDS_BYTES, stream, a); }
#else
    a.ph_lo = 0; a.ph_hi = NPHASE;
    void* args[] = {&a};
    hipError_t e = hipLaunchCooperativeKernel((const void*)mk_fwd, dim3(grid), dim3(512), args, LDS_BYTES, stream);
    if (e != hipSuccess) fprintf(stderr, "cooperative launch failed: %s (grid %d)\n", hipGetErrorString(e), grid);
#endif
}
```

```cpp
#include <hip/hip_runtime.h>
#include <hip/hip_cooperative_groups.h>
#include <cstdio>
#include <cstdint>
namespace cg = cooperative_groups;
namespace pg8 {
#define PG8_LAS __attribute__((address_space(3)))
typedef unsigned short bf16_t;
typedef short bf16x8 __attribute__((ext_vector_type(8)));
typedef float f32x4 __attribute__((ext_vector_type(4)));
typedef unsigned u32x4 __attribute__((ext_vector_type(4)));
constexpr int BM = 256, BK = 64, HALF = 128, HTB = HALF * BK * 2  , STAGE_BYTES = 8 * HTB, NXCD = 8, WGM = 8;

__host__ __device__ __forceinline__ int lds_byte(int r, int c) { const int st = (r >> 4) * 2 + (c >> 5), rr = r & 15, cc = c & 31, ob = rr * 64 + cc * 2; return st * 1024 + (ob ^ (((ob >> 9) & 1) << 5)); }
__host__ __device__ __forceinline__ void stage_rc(int b, int& R, int& C) { const int st = b / 1024, sb = b % 1024, swz = sb ^ (((sb >> 9) & 1) << 5); R = (st >> 1) * 16 + swz / 64; C = (st & 1) * 32 + (swz % 64) / 2; }
__host__ __device__ __forceinline__ int perm32(int rho) { const int n = rho >> 4, i = rho & 15; return 8 * (i >> 2) + 4 * n + (i & 3); }

struct Unit { int pm, pn, koff, nt; };
struct Gemm { const bf16_t* A; const bf16_t* Bt; int M, N, K; };

struct StaticOrder {
    int nM, nN, nwg, G, c, ntf;
    __host__ __device__ __forceinline__ void init(int M, int N, int G_, int c_, int K_) { nM = M / BM; nN = N / BM; nwg = nM * nN; G = G_; c = c_; ntf = K_ / BK; }
    __host__ __device__ __forceinline__ bool next(int i, Unit& u) const {
        const long L = (long)i * G + c; if (L >= nwg) return false;
        int wgid = (int)L; { const int q = nwg / NXCD, r = nwg % NXCD, xcd = wgid % NXCD, off = wgid / NXCD; wgid = (xcd < r ? xcd * (q + 1) : r * (q + 1) + (xcd - r) * q) + off; }
        const int nig = WGM * nN, gid = wgid / nig, fm = gid * WGM, gsz = (nM - fm) < WGM ? (nM - fm) : WGM;
        u.pm = fm + ((wgid % nig) % gsz); u.pn = (wgid % nig) / gsz; u.koff = 0; u.nt = ntf; return true;
    }
    __device__ __forceinline__ void a_ready(const Unit&) const {}
    __device__ __forceinline__ void done(const Unit&) const {}
};

template <class Epi, class Sched, bool ALIGN_EPI = false, bool SP2 = false>
__device__ __forceinline__ void gemm_phase(PG8_LAS unsigned char* lds, const Gemm g, const Sched& S, const Epi& E) {
    const int tid = threadIdx.x, wid = __builtin_amdgcn_readfirstlane(tid >> 6), lane = tid & 63, wr = wid >> 2, wc = wid & 3, fr = lane & 15, fq = lane >> 4;
    const int K = g.K;
    unsigned voffA[2], voffB[2];
#pragma unroll
    for (int i = 0; i < 2; ++i) { int R, C; stage_rc(tid * 16 + i * 8192, R, C); const int Rb = Epi::PERM ? ((R & ~31) + perm32(R & 31)) : R;
        voffA[i] = (unsigned)(R * K + C) * 2u; voffB[i] = (unsigned)(Rb * K + C) * 2u; }
    const size_t kstep = (size_t)(BK * 2);
    const size_t hstep = (size_t)HALF * K * 2;
    const size_t tstep = 2 * hstep;
    const unsigned ldsw = (unsigned)wid * 1024u;
    const int aoff = lds_byte(wr * 64 + fr, fq * 8), boff = lds_byte(wc * 32 + fr, fq * 8);
#define PG8_SA(b, h) (((b) * 2 + (h)) * HTB)
#define PG8_SB(b, h) ((4 + (b) * 2 + (h)) * HTB)
#define PG8_STAGE(bufoff, gbase, voff) do { _Pragma("unroll") for (int _i = 0; _i < 2; ++_i) \
        __builtin_amdgcn_global_load_lds((const unsigned*)((const char*)(gbase) + (voff)[_i]), (PG8_LAS unsigned*)(lds + (bufoff) + ldsw + _i * 8192), 16, 0, 0); } while (0)
#define PG8_LDA(dst, b, h) do { _Pragma("unroll") for (int m = 0; m < 4; ++m) _Pragma("unroll") for (int k = 0; k < 2; ++k) dst[m][k] = *(const PG8_LAS bf16x8*)(lds + PG8_SA(b, h) + aoff + m * 2048 + k * 1024); } while (0)
#define PG8_LDB(dst, b, h) do { _Pragma("unroll") for (int n = 0; n < 2; ++n) _Pragma("unroll") for (int k = 0; k < 2; ++k) dst[n][k] = *(const PG8_LAS bf16x8*)(lds + PG8_SB(b, h) + boff + n * 2048 + k * 1024); } while (0)
#define PG8_MMA(ai, bj, At, Bt) do { __builtin_amdgcn_s_setprio(1); _Pragma("unroll") for (int m = 0; m < 4; ++m) _Pragma("unroll") for (int n = 0; n < 2; ++n) _Pragma("unroll") for (int k = 0; k < 2; ++k) \
        acc[ai][bj][m][n] = __builtin_amdgcn_mfma_f32_16x16x32_bf16(Bt[n][k], At[m][k], acc[ai][bj][m][n], 0, 0, 0); __builtin_amdgcn_s_setprio(0); } while (0)
#define PG8_WAIT_V(n) asm volatile("s_waitcnt vmcnt(" #n ")" ::: "memory")
#define PG8_WAIT_L(n) asm volatile("s_waitcnt lgkmcnt(" #n ")" ::: "memory")
#define PG8_BAR __builtin_amdgcn_s_barrier()
#define PG8_SCHED __builtin_amdgcn_sched_barrier(0)
    Unit cur, nxt; int ui = 0;
    if (!S.next(0, cur)) return;
    f32x4 acc[2][2][4][2];
#pragma unroll
    for (int a = 0; a < 2; ++a)
#pragma unroll
        for (int b = 0; b < 2; ++b)
#pragma unroll
            for (int m = 0; m < 4; ++m)
#pragma unroll
                for (int n = 0; n < 2; ++n) acc[a][b][m][n] = (f32x4){0.f, 0.f, 0.f, 0.f};
    bf16x8 At[4][2], B0[2][2], B1[2][2];
    const char* cA = (const char*)g.A + (size_t)cur.pm * tstep + (size_t)cur.koff * 2; const char* cB = (const char*)g.Bt + (size_t)cur.pn * tstep + (size_t)cur.koff * 2;
    S.a_ready(cur);
    if constexpr (SP2) {
        PG8_STAGE(PG8_SB(0, 0), cB, voffB); PG8_STAGE(PG8_SB(0, 1), cB + hstep, voffB); PG8_STAGE(PG8_SA(0, 0), cA, voffA); PG8_STAGE(PG8_SA(0, 1), cA + hstep, voffA);
        if (wr == 1) PG8_BAR;
        PG8_WAIT_V(2); PG8_BAR;
        PG8_STAGE(PG8_SB(1, 0), cB + kstep, voffB); PG8_STAGE(PG8_SA(1, 0), cA + kstep, voffA); PG8_STAGE(PG8_SB(1, 1), cB + hstep + kstep, voffB);
        PG8_WAIT_V(6); PG8_BAR;
    } else {
        PG8_STAGE(PG8_SB(0, 0), cB, voffB); PG8_STAGE(PG8_SA(0, 0), cA, voffA); PG8_STAGE(PG8_SB(0, 1), cB + hstep, voffB); PG8_STAGE(PG8_SA(0, 1), cA + hstep, voffA);
        if (wr == 1) PG8_BAR;
        PG8_WAIT_V(4); PG8_BAR;
        PG8_STAGE(PG8_SB(1, 0), cB + kstep, voffB); PG8_STAGE(PG8_SA(1, 0), cA + kstep, voffA); PG8_STAGE(PG8_SB(1, 1), cB + hstep + kstep, voffB);
        PG8_WAIT_V(6); PG8_BAR;
    }
    for (;;) {
        const bool has_next = S.next(ui + 1, nxt);
        const char* nA = has_next ? (const char*)g.A + (size_t)nxt.pm * tstep + (size_t)nxt.koff * 2 : cA; const char* nB = has_next ? (const char*)g.Bt + (size_t)nxt.pn * tstep + (size_t)nxt.koff * 2 : cB;
        const int nt = cur.nt;
        for (int t = 0; t < nt; t += 2) {
            const bool last = (t == nt - 2);
            if constexpr (Epi::MIDK) { if (t == Epi::MIDT && cur.pm < Epi::MIDPM) E.mid(acc, cur, wr, wc, fr, fq); }
            const char* a1 = cA + (size_t)(t + 1) * kstep;
            const char* a2 = last ? nA : cA + (size_t)(t + 2) * kstep; const char* b2 = last ? nB : cB + (size_t)(t + 2) * kstep;
            const char* a3 = a2 + kstep; const char* b3 = b2 + kstep;
            if (last && has_next) S.a_ready(nxt);
            if constexpr (SP2) {
            PG8_LDB(B0, 0, 0); PG8_LDB(B1, 0, 1); PG8_SCHED; PG8_LDA(At, 0, 0); PG8_STAGE(PG8_SA(1, 1), a1 + hstep, voffA);
            PG8_WAIT_V(8); PG8_WAIT_L(0); PG8_BAR; PG8_MMA(0, 0, At, B0); PG8_MMA(0, 1, At, B1); PG8_BAR; PG8_SCHED;
            PG8_LDA(At, 0, 1); PG8_STAGE(PG8_SB(0, 0), b2, voffB); PG8_STAGE(PG8_SB(0, 1), b2 + hstep, voffB); PG8_STAGE(PG8_SA(0, 0), a2, voffA);
            PG8_WAIT_V(8); PG8_WAIT_L(0); PG8_BAR; PG8_MMA(1, 0, At, B0); PG8_MMA(1, 1, At, B1); PG8_BAR; PG8_SCHED;
            PG8_LDB(B0, 1, 0); PG8_LDB(B1, 1, 1); PG8_SCHED; PG8_LDA(At, 1, 0); PG8_STAGE(PG8_SA(0, 1), a2 + hstep, voffA);
            PG8_WAIT_V(8); PG8_WAIT_L(0); PG8_BAR; PG8_MMA(0, 0, At, B0); PG8_MMA(0, 1, At, B1); PG8_BAR; PG8_SCHED;
            PG8_LDA(At, 1, 1); PG8_STAGE(PG8_SB(1, 0), b3, voffB); PG8_STAGE(PG8_SB(1, 1), b3 + hstep, voffB); PG8_STAGE(PG8_SA(1, 0), a3, voffA);
            PG8_WAIT_V(8); PG8_WAIT_L(0); PG8_BAR; PG8_MMA(1, 0, At, B0); PG8_MMA(1, 1, At, B1); PG8_BAR; PG8_SCHED;
            } else {
            PG8_LDB(B0, 0, 0); PG8_SCHED; PG8_LDA(At, 0, 0); PG8_STAGE(PG8_SA(1, 1), a1 + hstep, voffA);
            PG8_WAIT_L(8); PG8_BAR; PG8_WAIT_L(0); PG8_MMA(0, 0, At, B0); PG8_BAR; PG8_SCHED;
            PG8_LDB(B1, 0, 1); PG8_STAGE(PG8_SB(0, 0), b2, voffB);
            PG8_BAR; PG8_WAIT_L(0); PG8_MMA(0, 1, At, B1); PG8_BAR;
            PG8_LDA(At, 0, 1); PG8_STAGE(PG8_SA(0, 0), a2, voffA);
            PG8_BAR; PG8_WAIT_L(0); PG8_MMA(1, 0, At, B0); PG8_BAR; PG8_SCHED;
            PG8_STAGE(PG8_SB(0, 1), b2 + hstep, voffB);
            PG8_WAIT_V(6); PG8_BAR; PG8_MMA(1, 1, At, B1); PG8_BAR;
            PG8_LDB(B0, 1, 0); PG8_SCHED; PG8_LDA(At, 1, 0); PG8_STAGE(PG8_SA(0, 1), a2 + hstep, voffA);
            PG8_WAIT_L(8); PG8_BAR; PG8_WAIT_L(0); PG8_MMA(0, 0, At, B0); PG8_BAR; PG8_SCHED;
            PG8_LDB(B1, 1, 1); PG8_STAGE(PG8_SB(1, 0), b3, voffB);
            PG8_BAR; PG8_WAIT_L(0); PG8_MMA(0, 1, At, B1); PG8_BAR;
            PG8_LDA(At, 1, 1); PG8_STAGE(PG8_SA(1, 0), a3, voffA);
            PG8_BAR; PG8_WAIT_L(0); PG8_MMA(1, 0, At, B0); PG8_BAR; PG8_SCHED;
            PG8_STAGE(PG8_SB(1, 1), b3 + hstep, voffB);
            PG8_WAIT_V(6); PG8_BAR; PG8_MMA(1, 1, At, B1); PG8_BAR;
            }
        }
        if constexpr (ALIGN_EPI) { if (wr == 0) PG8_BAR; }
        if constexpr (!Epi::AFTER_DRAIN) { E(acc, cur, wr, wc, fr, fq); S.done(cur); }
        if (!has_next) break;
#pragma unroll
        for (int a = 0; a < 2; ++a)
#pragma unroll
            for (int b = 0; b < 2; ++b)
#pragma unroll
                for (int m = 0; m < 4; ++m)
#pragma unroll
                    for (int n = 0; n < 2; ++n) acc[a][b][m][n] = (f32x4){0.f, 0.f, 0.f, 0.f};
        cur = nxt; cA = nA; cB = nB; ++ui;
        if constexpr (ALIGN_EPI) { if (wr == 1) PG8_BAR; }
    }
    PG8_WAIT_V(0);
    if constexpr (!ALIGN_EPI) { if (wr == 0) PG8_BAR; }
    PG8_BAR;
    if constexpr (Epi::AFTER_DRAIN) { E.fused(acc, cur, wr, wc, fr, fq, lds, wid, lane); S.done(cur); }
#undef PG8_SA
#undef PG8_SB
#undef PG8_STAGE
#undef PG8_LDA
#undef PG8_LDB
#undef PG8_MMA
#undef PG8_WAIT_V
#undef PG8_WAIT_L
#undef PG8_BAR
#undef PG8_SCHED
}
}

#ifndef REP_ATT
#define REP_ATT 1
#endif
#ifndef REP_GEMM
#define REP_GEMM 1
#endif
#ifndef MK_MULTI
#define MK_MULTI 0
#endif
namespace mk {
using pg8::bf16_t; using pg8::bf16x8; using pg8::f32x4; using pg8::u32x4;
typedef float f32x16 __attribute__((ext_vector_type(16)));
typedef unsigned u32x2 __attribute__((ext_vector_type(2)));
#define LAS __attribute__((address_space(3)))
#define DI __device__ __forceinline__

#define XB_TMO      128
#define XB_XCNT(j)  (256  + 64 * (j))
#define XB_XSUB(j)  (1280 + 64 * (j))
#define XB_XGEN(j)  (2304 + 64 * (j))
#define XB_TOP      3328
#define XB_TOPGEN   3392
#define XCD_BAR_WORDS 3456
#define XB_SPIN_CAP (1u << 18)

__device__ __forceinline__ unsigned xb_ld(unsigned* p)              { return __hip_atomic_load(p, __ATOMIC_RELAXED, __HIP_MEMORY_SCOPE_AGENT); }
__device__ __forceinline__ unsigned xb_add(unsigned* p, unsigned v) { return __hip_atomic_fetch_add(p, v, __ATOMIC_RELAXED, __HIP_MEMORY_SCOPE_AGENT); }
__device__ __forceinline__ unsigned xb_xcc_id() { return (unsigned)__builtin_amdgcn_s_getreg((3 << 11) | 20) & 0xFu; }
#define XB_SPIN(cond, bar) do { unsigned _sp = 0; while (cond) { __builtin_amdgcn_s_sleep(1); \
    if ((++_sp & 255u) == 0u) { if (xb_ld(&(bar)[XB_TMO])) break; if (_sp > XB_SPIN_CAP) { atomicAdd(&(bar)[XB_TMO], 1u); break; } } } } while (0)

struct XcdBarrier {
    unsigned* bar; unsigned x;
    volatile LAS unsigned* st;
};

__device__ __forceinline__ XcdBarrier xcd_barrier_post(unsigned* bar, volatile LAS unsigned* st) {
    XcdBarrier b; b.bar = bar; b.x = xb_xcc_id(); b.st = st;
    if (threadIdx.x == 0) (void)xb_add(&bar[XB_XCNT(b.x)], 1u);
    return b;
}
__device__ __forceinline__ void xcd_barrier_complete(unsigned* bar, unsigned x, unsigned& nloc, unsigned& nx) {
    const unsigned G = gridDim.x * gridDim.y * gridDim.z;
    unsigned sum, cnt, mine, sp = 0u;
    for (;;) {
        sum = 0u; cnt = 0u; mine = 0u;
#pragma unroll
        for (unsigned j = 0; j < 16; ++j) { const unsigned c = xb_ld(&bar[XB_XCNT(j)]); sum += c; cnt += (c > 0u) ? 1u : 0u; mine = (j == x) ? c : mine; }
        if (sum == G) break;
        __builtin_amdgcn_s_sleep(1);
        if ((++sp & 255u) == 0u) { if (xb_ld(&bar[XB_TMO])) break; if (sp > XB_SPIN_CAP) { atomicAdd(&bar[XB_TMO], 1u); break; } }
    }
    nloc = mine > 0u ? mine : 1u; nx = cnt > 0u ? cnt : 1u;
}

__device__ __forceinline__ void xcd_barrier(const XcdBarrier& b) {
    asm volatile("s_waitcnt vmcnt(0)" ::: "memory");
    __syncthreads();
    if (threadIdx.x == 0) {
        unsigned* bar = b.bar;
        __builtin_amdgcn_s_waitcnt(0);
        unsigned nloc = b.st[0], nx = b.st[1];
        if (nloc == 0u) { xcd_barrier_complete(bar, b.x, nloc, nx); b.st[0] = nloc; b.st[1] = nx; }
        const unsigned old = xb_add(&bar[XB_XSUB(b.x)], 1u);
        const unsigned gen = old / nloc;
        if (old + 1u == (gen + 1u) * nloc) {
            __builtin_amdgcn_fence(__ATOMIC_RELEASE, "agent");
            asm volatile("s_waitcnt vmcnt(0)" ::: "memory");
            const unsigned og = xb_add(&bar[XB_TOP], 1u);
            const unsigned tg = og / nx;
            if (og + 1u == (tg + 1u) * nx) xb_add(&bar[XB_TOPGEN], 1u);
            else XB_SPIN(xb_ld(&bar[XB_TOPGEN]) == tg, bar);
            __builtin_amdgcn_fence(__ATOMIC_ACQUIRE, "agent");
            xb_add(&bar[XB_XGEN(b.x)], 1u);
            asm volatile("s_waitcnt vmcnt(0)" ::: "memory");
        } else {
            XB_SPIN(xb_ld(&bar[XB_XGEN(b.x)]) == gen, bar);
            __builtin_amdgcn_fence(__ATOMIC_ACQUIRE, "agent");
            asm volatile("s_waitcnt vmcnt(0)" ::: "memory");
        }
    }
    __syncthreads();
}

constexpr int MP = 16384, MS = 1024, M = MP + MS, D = 1024, NIN = 3080, NINP = 3328, DFF = 2816, TS = 1088, TP = 8192;
constexpr float LOG2E = 1.4426950408889634f, C2 = 0.125f * LOG2E, EPS = 1e-6f;
constexpr size_t O_YP = 0, O_YS = 16777216, O_SBKP = 17825792, O_LFP = 51380224, O_SBKS = 51511296, O_LFS = 53608448;
constexpr size_t KVP_SZ = 8388608, KVS_SZ = 524288;
constexpr size_t MiB = 1u << 20;
constexpr size_t WS_ADA = 0, ADA_BYTES = 18 * 6144 * 4, WS_BAR = 512 * 1024, WS_KMAX = WS_BAR + 16384, WS_CTR = WS_KMAX + 256, CTL_BYTES = WS_CTR + 256;
constexpr size_t WS_FCP = 1 * MiB, WS_FCS = 2 * MiB, WS_SS = 3 * MiB;
constexpr size_t WS_WIN = 5 * MiB, WS_WO = 12 * MiB, WS_WGU = 14 * MiB, WS_WD = 25 * MiB;
constexpr size_t WS_HN = 32 * MiB, WS_QB = 66 * MiB, WS_KP = 100 * MiB, WS_VP = 132 * MiB, WS_KS = 164 * MiB, WS_VS = 198 * MiB;
constexpr size_t WS_HFF = 66 * MiB;
constexpr size_t WS_X1 = 188 * MiB;
static_assert(WS_KP == 100 * MiB && WS_VP == 132 * MiB && WS_KS == 164 * MiB && WS_VS == 198 * MiB && WS_HFF + (size_t)M * DFF * 2 <= WS_X1 && WS_X1 + (size_t)M * D * 4 <= 256 * MiB, "ws map");
constexpr int LDS_BYTES = 135168;

DI unsigned pk2(float lo, float hi) { typedef float f2 __attribute__((ext_vector_type(2))); typedef __bf16 b2 __attribute__((ext_vector_type(2))); f2 v = {lo, hi}; b2 b = __builtin_convertvector(v, b2); return __builtin_bit_cast(unsigned, b); }
DI float bf2f(unsigned short b) { return __uint_as_float((unsigned)b << 16); }
DI float ex2(float x) { return __builtin_amdgcn_exp2f(x); }
DI float lg2(float x) { return __builtin_amdgcn_logf(x); }
DI float wave_sum(float v) {
#pragma unroll
    for (int o = 1; o < 64; o <<= 1) v += __shfl_xor(v, o);
    return v;
}
DI int row_batch(int row) { return row < MP ? (row >> 13) : 2 + ((row - MP) >> 6); }
DI float logsig(float x) { return fminf(x, 0.f) - log1pf(expf(-fabsf(x))); }

struct EpiIn {
    static constexpr bool PERM = false, AFTER_DRAIN = false, MIDK = false;
    float* out; bf16_t* Qb; unsigned char* ws; const float* b_f;
    DI void operator()(const f32x4 (&acc)[2][2][4][2], const pg8::Unit& u, int wr, int wc, int fr, int fq) const {
        const int pn = u.pn, type = pn >> 1, half = (pn & 1) * 256;
        if (type == 6) {
            if (wc == 0 && fq < 2) {
                const f32x4 bf = *(const f32x4*)(b_f + fq * 4);
#pragma unroll
                for (int ai = 0; ai < 2; ++ai)
#pragma unroll
                    for (int m = 0; m < 4; ++m) {
                        const int row = u.pm * 256 + ai * 128 + wr * 64 + m * 16 + fr;
                        const f32x4 v = acc[ai][0][m][0] + bf;
                        f32x4 lf; lf[0] = logsig(v[0]); lf[1] = logsig(v[1]); lf[2] = logsig(v[2]); lf[3] = logsig(v[3]);
                        float* dst = row < MP ? out + O_LFP + (size_t)row * 8 : out + O_LFS + (size_t)(row - MP) * 8;
                        *(f32x4*)(dst + fq * 4) = lf;
                    }
            }
            return;
        }
        const int cofs = half + wc * 32 + fq * 4;
        if (type == 0 || type == 3) {
#pragma unroll
            for (int ai = 0; ai < 2; ++ai)
#pragma unroll
                for (int m = 0; m < 4; ++m) {
                    const int row = u.pm * 256 + ai * 128 + wr * 64 + m * 16 + fr;
                    bf16_t* q = Qb + (size_t)row * 1024 + (type == 3 ? 512 : 0) + cofs;
#pragma unroll
                    for (int bj = 0; bj < 2; ++bj)
#pragma unroll
                        for (int n = 0; n < 2; ++n) { const f32x4 v = acc[ai][bj][m][n] * C2; u32x2 w; w.x = pk2(v[0], v[1]); w.y = pk2(v[2], v[3]); *(u32x2*)(q + bj * 128 + n * 16) = w; }
                }
            return;
        }
        const int isv = (type == 2 || type == 5) ? 1 : 0, grp = type >= 3 ? 1 : 0;
#pragma unroll
        for (int ai = 0; ai < 2; ++ai)
#pragma unroll
            for (int m = 0; m < 4; ++m) {
                const int row = u.pm * 256 + ai * 128 + wr * 64 + m * 16 + fr;
                const bool samp = row >= MP; const int s = row - MP;
                float* fo = out + (samp ? O_SBKS + (size_t)(isv + 2 * grp) * KVS_SZ + (size_t)s * 512 : O_SBKP + (size_t)(isv + 2 * grp) * KVP_SZ + (size_t)row * 512) + cofs;
                const size_t brow = samp ? (size_t)s : (size_t)row;
                bf16_t* bo = (bf16_t*)(ws + MiB * (size_t)(100 + 32 * isv + (samp ? 64 + 2 * isv : 0))) + brow * 1024 + grp * 512 + cofs;
#pragma unroll
                for (int bj = 0; bj < 2; ++bj)
#pragma unroll
                    for (int n = 0; n < 2; ++n) { const f32x4 v = acc[ai][bj][m][n]; *(f32x4*)(fo + bj * 128 + n * 16) = v; u32x2 w; w.x = pk2(v[0], v[1]); w.y = pk2(v[2], v[3]); *(u32x2*)(bo + bj * 128 + n * 16) = w; }
            }
    }
};
DI void row_rstd2(const float* ssb, int row, float& r_sb, float& r_fx) {
    const f32x4* sp = (const f32x4*)(ssb + (size_t)row * 16); const f32x4 s0 = sp[0], s1 = sp[1], s2 = sp[2], s3 = sp[3];
    r_sb = 1.0f / sqrtf(((s0[0] + s0[1]) + (s0[2] + s0[3]) + (s1[0] + s1[1]) + (s1[2] + s1[3])) * (1.0f / 512.0f) + EPS);
    r_fx = 1.0f / sqrtf(((s2[0] + s2[1]) + (s2[2] + s2[3]) + (s3[0] + s3[1]) + (s3[2] + s3[3])) * (1.0f / 512.0f) + EPS);
}
template <bool NORM2> struct EpiRes {
    static constexpr bool PERM = false, AFTER_DRAIN = false, MIDK = NORM2; static constexpr int MIDT = 8, MIDPM = 64;
    const float* xp; const float* ada; int gate_off; bf16_t* X1; int mode; float* partA; float* partB; const float* ssb;
    DI void mid(f32x4 (&acc)[2][2][4][2], const pg8::Unit& u, int wr, int wc, int fr, int fq) const {
        const int r0 = u.pm * 256 + wr * 64 + fq * 16 + fr;
        float s0, f0, s1, f1; row_rstd2(ssb, r0, s0, f0); row_rstd2(ssb, r0 + 128, s1, f1);
        const float q0 = s0 / f0, q1 = s1 / f1;
#pragma unroll
        for (int ai = 0; ai < 2; ++ai)
#pragma unroll
            for (int m = 0; m < 4; ++m) { const float ratio = __shfl(ai ? q1 : q0, fr + 16 * m);
#pragma unroll
                for (int bj = 0; bj < 2; ++bj)
#pragma unroll
                    for (int n = 0; n < 2; ++n) acc[ai][bj][m][n] *= ratio; }
    }
    DI void operator()(const f32x4 (&acc)[2][2][4][2], const pg8::Unit& u, int wr, int wc, int fr, int fq) const {
        const int col0 = u.pn * 256 + wc * 32 + fq * 4;
        if (u.pm >= 64) {
            const int s = u.koff / (u.nt * 64);
            float* pp = (s < 8 ? partA + (size_t)s * 1048576 : partB + (size_t)(s - 8) * 1048576) + col0;
#pragma unroll
            for (int ai = 0; ai < 2; ++ai)
#pragma unroll
                for (int m = 0; m < 4; ++m) {
                    float* po = pp + (size_t)((u.pm - 64) * 256 + ai * 128 + wr * 64 + m * 16 + fr) * 1024;
#pragma unroll
                    for (int bj = 0; bj < 2; ++bj)
#pragma unroll
                        for (int n = 0; n < 2; ++n) *(f32x4*)(po + bj * 128 + n * 16) = acc[ai][bj][m][n];
                }
            return;
        }
        const int row0 = u.pm * 256 + wr * 64 + fr;
        const float* g = ada + (size_t)(u.pm >> 5) * 6144 + gate_off + col0;
        f32x4 gp1[2][2];
#pragma unroll
        for (int bj = 0; bj < 2; ++bj)
#pragma unroll
            for (int n = 0; n < 2; ++n) gp1[bj][n] = *(const f32x4*)(g + bj * 128 + n * 16) + 1.0f;
        float rf0 = 1.0f, rf1 = 1.0f;
        if (NORM2) { float t0, t1; row_rstd2(ssb, row0 + fq * 16, t0, rf0); row_rstd2(ssb, row0 + fq * 16 + 128, t1, rf1); }
        if constexpr (NORM2) {
            f32x4 bc[2][2];
            { const float* base = xp + (size_t)row0 * 1024 + col0;
#pragma unroll
                for (int bj = 0; bj < 2; ++bj)
#pragma unroll
                    for (int n = 0; n < 2; ++n) bc[bj][n] = *(const f32x4*)(base + bj * 128 + n * 16); }
#pragma unroll
            for (int gi = 0; gi < 8; ++gi) {
                const int ai = gi >> 2, m = gi & 3;
                f32x4 bn[2][2];
                if (gi < 7) { const float* base = xp + (size_t)(row0 + ((gi + 1) >> 2) * 128 + ((gi + 1) & 3) * 16) * 1024 + col0;
#pragma unroll
                    for (int bj = 0; bj < 2; ++bj)
#pragma unroll
                        for (int n = 0; n < 2; ++n) bn[bj][n] = *(const f32x4*)(base + bj * 128 + n * 16); }
                const float rs = __shfl(ai ? rf1 : rf0, fr + 16 * m);
                bf16_t* xo = X1 + (size_t)(row0 + ai * 128 + m * 16) * 1024 + col0;
#pragma unroll
                for (int bj = 0; bj < 2; ++bj)
#pragma unroll
                    for (int n = 0; n < 2; ++n) { const f32x4 o = bc[bj][n] + gp1[bj][n] * (acc[ai][bj][m][n] * rs); u32x2 w; w.x = pk2(o[0], o[1]); w.y = pk2(o[2], o[3]); *(u32x2*)(xo + bj * 128 + n * 16) = w; }
                if (gi < 7) {
#pragma unroll
                    for (int bj = 0; bj < 2; ++bj)
#pragma unroll
                        for (int n = 0; n < 2; ++n) bc[bj][n] = bn[bj][n]; }
            }
        } else {
            u32x2 bc[2][2];
            { const bf16_t* xo = X1 + (size_t)row0 * 1024 + col0;
#pragma unroll
                for (int bj = 0; bj < 2; ++bj)
#pragma unroll
                    for (int n = 0; n < 2; ++n) bc[bj][n] = *(const u32x2*)(xo + bj * 128 + n * 16); }
#pragma unroll
            for (int gi = 0; gi < 8; ++gi) {
                const int ai = gi >> 2, m = gi & 3;
                u32x2 bn[2][2];
                if (gi < 7) { const bf16_t* xn = X1 + (size_t)(row0 + ((gi + 1) >> 2) * 128 + ((gi + 1) & 3) * 16) * 1024 + col0;
#pragma unroll
                    for (int bj = 0; bj < 2; ++bj)
#pragma unroll
                        for (int n = 0; n < 2; ++n) bn[bj][n] = *(const u32x2*)(xn + bj * 128 + n * 16); }
                bf16_t* xo = X1 + (size_t)(row0 + ai * 128 + m * 16) * 1024 + col0;
#pragma unroll
                for (int bj = 0; bj < 2; ++bj)
#pragma unroll
                    for (int n = 0; n < 2; ++n) { const u32x2 bw = bc[bj][n]; f32x4 bv; bv[0] = __uint_as_float(bw.x << 16); bv[1] = __uint_as_float(bw.x & 0xffff0000u); bv[2] = __uint_as_float(bw.y << 16); bv[3] = __uint_as_float(bw.y & 0xffff0000u);
                        const f32x4 o = bv + gp1[bj][n] * acc[ai][bj][m][n]; u32x2 w; w.x = pk2(o[0], o[1]); w.y = pk2(o[2], o[3]); *(u32x2*)(xo + bj * 128 + n * 16) = w; }
                if (gi < 7) {
#pragma unroll
                    for (int bj = 0; bj < 2; ++bj)
#pragma unroll
                        for (int n = 0; n < 2; ++n) bc[bj][n] = bn[bj][n]; }
            }
        }
    }
};
struct TailOrder {
    pg8::StaticOrder so; int S, ntk;
    DI void init(int G, int c, int K, int S_) { so.init(MP, 1024, G, c, K); S = S_; ntk = (K / 64) / S_; }
    DI bool next(int i, pg8::Unit& u) const {
        const long L = (long)i * so.G + so.c;
        if (L < so.nwg) return so.next(i, u);
        const int j = (int)(L - so.nwg); if (j >= 16 * S) return false;
        const int su = j / S, sp = j % S;
        u.pm = 64 + (su >> 2); u.pn = su & 3; u.koff = sp * ntk * 64; u.nt = ntk; return true;
    }
    DI void a_ready(const pg8::Unit&) const {}
    DI void done(const pg8::Unit&) const {}
};
struct EpiUp {
    static constexpr bool PERM = false, AFTER_DRAIN = false, MIDK = false;
    bf16_t* H;
    DI void operator()(const f32x4 (&acc)[2][2][4][2], const pg8::Unit& u, int wr, int wc, int fr, int fq) const {
#pragma unroll
        for (int ai = 0; ai < 2; ++ai)
#pragma unroll
            for (int m = 0; m < 4; ++m) {
                const int row = u.pm * 256 + ai * 128 + wr * 64 + m * 16 + fr;
                bf16_t* h = H + (size_t)row * DFF + u.pn * 128 + wc * 32 + fq * 4;
#pragma unroll
                for (int n = 0; n < 2; ++n) { const f32x4 g = acc[ai][0][m][n], up = acc[ai][1][m][n]; f32x4 v;
#pragma unroll
                    for (int e = 0; e < 4; ++e) v[e] = g[e] * __builtin_amdgcn_rcpf(1.0f + ex2(-g[e] * LOG2E)) * up[e];
                    u32x2 w; w.x = pk2(v[0], v[1]); w.y = pk2(v[2], v[3]); *(u32x2*)(h + n * 16) = w; }
            }
    }
};

constexpr int TILE_B = 64 * 144;
#define MFMA32(a, b, c) __builtin_amdgcn_mfma_f32_32x32x16_bf16((a), (b), (c), 0, 0, 0)
DI void attn_unit(LAS unsigned char* lds, const int type, const bf16_t* __restrict__ Q, const bf16_t* __restrict__ K, const bf16_t* __restrict__ V, const float* __restrict__ cK, const float* __restrict__ cV,
                  bf16_t* O, float* ss, const float* fq, const float* fk, const int qpos0, const int nq, const float kmaxn) {
    const int tid = threadIdx.x, lane = tid & 63, wid = __builtin_amdgcn_readfirstlane(tid >> 6), r32 = lane & 31, hi = lane >> 5;
    LAS unsigned char* ldsK = lds; LAS unsigned char* ldsV = lds + 2 * TILE_B; LAS float* fkt = (LAS float*)(lds + 4 * TILE_B); LAS int* flags = (LAS int*)(lds + 4 * TILE_B + 512);
    const bool wactive = wid * 32 < nq;
    const int qrow = wid * 32 + r32, qpos = qpos0 + qrow;
    bf16x8 qr[4];
#pragma unroll
    for (int d0 = 0; d0 < 4; ++d0) { qr[d0] = (bf16x8){0, 0, 0, 0, 0, 0, 0, 0}; if (wactive) qr[d0] = *(const bf16x8*)(Q + (size_t)qrow * 1024 + d0 * 16 + hi * 8); }
    float fq2 = 0.f, qn = 0.f;
    if (type == 1 && wactive) { fq2 = fq[(size_t)qrow * 8] * LOG2E;
#pragma unroll
        for (int d0 = 0; d0 < 4; ++d0)
#pragma unroll
            for (int e = 0; e < 8; ++e) { const float f = bf2f((unsigned short)qr[d0][e]); qn += f * f; }
        qn += __shfl_xor(qn, 32); qn = sqrtf(qn) * kmaxn * 1.0001f; }
    const bool bound = (type == 1) && (kmaxn < 1e30f);
    if (bound) fq2 -= qn;
    f32x16 o0, o1;
#pragma unroll
    for (int r = 0; r < 16; ++r) { o0[r] = 0.f; o1[r] = 0.f; }
    float mrun = -INFINITY, lrun = 0.f, carry = 1.f;
    bool wave_done = !wactive;
    const int kt_hi = (qpos0 + nq - 1) >> 6, wkt = (qpos0 + wid * 32 + 31) >> 6;
    const int krow_l = tid >> 3, kch = tid & 7;
    const int prow = r32;
    const int kst = (krow_l & 32) + (krow_l & 3) + 8 * ((krow_l & 15) >> 2) + 4 * ((krow_l >> 4) & 1);
    u32x4 kregs[2], vregs[2]; float fkregs[2] = {0.f, 0.f};
#define AT_GLOAD(rs_, kt_) do { u32x4 kreg, vreg; float fkreg = 0.f; if (cK != nullptr && (kt_) < 16) { \
            const float* kp_ = cK + (size_t)((kt_) * 64 + krow_l) * 512 + kch * 8; const float* vp_ = cV + (size_t)((kt_) * 64 + lane) * 512 + wid * 8; \
            const f32x4 a0_ = *(const f32x4*)kp_, a1_ = *(const f32x4*)(kp_ + 4), b0_ = *(const f32x4*)vp_, b1_ = *(const f32x4*)(vp_ + 4); \
            kreg.x = pk2(a0_[0], a0_[1]); kreg.y = pk2(a0_[2], a0_[3]); kreg.z = pk2(a1_[0], a1_[1]); kreg.w = pk2(a1_[2], a1_[3]); \
            vreg.x = pk2(b0_[0], b0_[1]); vreg.y = pk2(b0_[2], b0_[3]); vreg.z = pk2(b1_[0], b1_[1]); vreg.w = pk2(b1_[2], b1_[3]); \
        } else { const int kr_ = (cK != nullptr) ? 0 : (kt_) * 64; \
            kreg = *(const u32x4*)(K + (size_t)(kr_ + krow_l) * 1024 + kch * 8); vreg = *(const u32x4*)(V + (size_t)(kr_ + lane) * 1024 + wid * 8); } \
        if (type == 1 && tid < 64) fkreg = fk[(size_t)((kt_) * 64 + tid) * 8] * LOG2E; \
        kregs[rs_] = kreg; vregs[rs_] = vreg; fkregs[rs_] = fkreg; } while (0)
#define AT_LSTORE(rs_, buf_) do { const u32x4 kreg = kregs[rs_], vreg = vregs[rs_]; const float fkreg = fkregs[rs_]; *(LAS u32x4*)(ldsK + (buf_) * TILE_B + kst * 144 + kch * 16) = kreg; \
        LAS unsigned short* vd_ = (LAS unsigned short*)(ldsV + (buf_) * TILE_B + (wid * 8) * 144 + lane * 2); \
        vd_[0] = (unsigned short)(vreg.x & 0xffffu); vd_[72] = (unsigned short)(vreg.x >> 16); vd_[144] = (unsigned short)(vreg.y & 0xffffu); vd_[216] = (unsigned short)(vreg.y >> 16); \
        vd_[288] = (unsigned short)(vreg.z & 0xffffu); vd_[360] = (unsigned short)(vreg.z >> 16); vd_[432] = (unsigned short)(vreg.w & 0xffffu); vd_[504] = (unsigned short)(vreg.w >> 16); \
        if (type == 1 && tid < 64) fkt[(buf_) * 64 + tid] = fkreg; } while (0)
    AT_GLOAD(0, kt_hi); AT_LSTORE(0, 0); __syncthreads();
    if (kt_hi >= 1) AT_GLOAD(1, kt_hi - 1);
    int kt = kt_hi;
    for (;;) {
#pragma unroll
      for (int buf = 0; buf < 2; ++buf) {
        if (kt >= 2) AT_GLOAD(buf, kt - 2);
        if (!wave_done && kt <= wkt) {
            const LAS unsigned char* Kb = ldsK + buf * TILE_B; const LAS unsigned char* Vb = ldsV + buf * TILE_B;
            f32x16 s0, s1;
            { const float ci = type == 1 ? fq2 : 0.f;
#pragma unroll
                for (int r = 0; r < 16; ++r) { s0[r] = ci; s1[r] = ci; } }
            {   bf16x8 ka[4], kb[4];
#pragma unroll
                for (int d0 = 0; d0 < 4; ++d0) { ka[d0] = *(const LAS bf16x8*)(Kb + prow * 144 + (d0 * 16 + hi * 8) * 2); kb[d0] = *(const LAS bf16x8*)(Kb + (32 + prow) * 144 + (d0 * 16 + hi * 8) * 2); }
                __builtin_amdgcn_s_setprio(1);
#pragma unroll
                for (int d0 = 0; d0 < 4; ++d0) { s0 = MFMA32(ka[d0], qr[d0], s0); s1 = MFMA32(kb[d0], qr[d0], s1); }
                __builtin_amdgcn_s_setprio(0);
            }
            const int kvb = kt * 64 + 16 * hi;
            if (type == 1) {
                const LAS f32x4* fk4 = (const LAS f32x4*)(fkt + buf * 64 + 16 * hi);
#pragma unroll
                for (int g = 0; g < 4; ++g) { const f32x4 a = fk4[g], b = fk4[8 + g];
#pragma unroll
                    for (int e = 0; e < 4; ++e) { s0[4 * g + e] -= a[e]; s1[4 * g + e] -= b[e]; } }
                if (kt * 64 + 63 > qpos0 + wid * 32) {
#pragma unroll
                    for (int r = 0; r < 16; ++r) { if (kvb + r > qpos) s0[r] = -INFINITY; if (kvb + 32 + r > qpos) s1[r] = -INFINITY; }
                }
                if (bound) {
                    if (kt == wkt) { float mx = __builtin_fmaxf(s0[0], s1[0]);
#pragma unroll
                        for (int r = 1; r < 16; ++r) mx = __builtin_fmaxf(mx, __builtin_fmaxf(s0[r], s1[r]));
                        mrun = __builtin_fmaxf(mx, __shfl_xor(mx, 32)); }
                    float ps = 0.f;
#pragma unroll
                    for (int r = 0; r < 16; ++r) { s0[r] = ex2(s0[r]); s1[r] = ex2(s1[r]); ps += s0[r] + s1[r]; }
                    lrun += ps;
                } else {
                    float mx = __builtin_fmaxf(s0[0], s1[0]);
#pragma unroll
                    for (int r = 1; r < 16; ++r) mx = __builtin_fmaxf(mx, __builtin_fmaxf(s0[r], s1[r]));
                    mx = __builtin_fmaxf(mx, __shfl_xor(mx, 32));
                    const float mnew = __builtin_fmaxf(mrun, mx), alpha = ex2(mrun - mnew); mrun = mnew;
                    float ps = 0.f;
#pragma unroll
                    for (int r = 0; r < 16; ++r) { s0[r] = ex2(s0[r] - mnew); s1[r] = ex2(s1[r] - mnew); ps += s0[r] + s1[r]; }
                    lrun = lrun * alpha + ps;
                    if (__any(alpha != 1.0f)) {
#pragma unroll
                        for (int r = 0; r < 16; ++r) { o0[r] *= alpha; o1[r] *= alpha; } }
                }
            } else {
                f32x16 l0, l1; float T0 = 1.f, T1 = 1.f;
#pragma unroll
                for (int r = 0; r < 16; ++r) {
                    const float t0 = s0[r], t1 = s1[r];
                    const float e0 = ex2(-fabsf(t0)), e1 = ex2(-fabsf(t1));
                    float k0 = (t0 >= 0.f ? e0 : 1.0f) * __builtin_amdgcn_rcpf(1.0f + e0), k1 = (t1 >= 0.f ? e1 : 1.0f) * __builtin_amdgcn_rcpf(1.0f + e1);
                    if (!(kvb + r < qpos)) k0 = 1.f;
                    if (!(kvb + 32 + r < qpos)) k1 = 1.f;
                    l0[r] = k0; l1[r] = k1; T0 *= k0; T1 *= k1;
                }
                const float U0 = __shfl_xor(T0, 32), U1 = __shfl_xor(T1, 32);
                float run = carry * (hi ? 1.f : U1);
#pragma unroll
                for (int r = 15; r >= 0; --r) { const float prev = run; run *= l1[r]; s1[r] = prev - run; }
                run = carry * (hi ? (T1 * U1) : (U1 * T1 * U0));
#pragma unroll
                for (int r = 15; r >= 0; --r) { const float prev = run; run *= l0[r]; s0[r] = prev - run; }
                carry *= (T0 * T1) * (U0 * U1);
            }
#pragma unroll
            for (int c = 0; c < 4; ++c) {
                u32x4 pw;
                if (c == 0)      { pw.x = pk2(s0[0], s0[1]); pw.y = pk2(s0[2], s0[3]); pw.z = pk2(s0[4], s0[5]); pw.w = pk2(s0[6], s0[7]); }
                else if (c == 1) { pw.x = pk2(s0[8], s0[9]); pw.y = pk2(s0[10], s0[11]); pw.z = pk2(s0[12], s0[13]); pw.w = pk2(s0[14], s0[15]); }
                else if (c == 2) { pw.x = pk2(s1[0], s1[1]); pw.y = pk2(s1[2], s1[3]); pw.z = pk2(s1[4], s1[5]); pw.w = pk2(s1[6], s1[7]); }
                else             { pw.x = pk2(s1[8], s1[9]); pw.y = pk2(s1[10], s1[11]); pw.z = pk2(s1[12], s1[13]); pw.w = pk2(s1[14], s1[15]); }
                const bf16x8 pf = __builtin_bit_cast(bf16x8, pw);
                const int kvoff = 32 * (c >> 1) + 16 * hi + 8 * (c & 1);
                const bf16x8 va = *(const LAS bf16x8*)(Vb + r32 * 144 + kvoff * 2);
                const bf16x8 vb = *(const LAS bf16x8*)(Vb + (32 + r32) * 144 + kvoff * 2);
                o0 = MFMA32(va, pf, o0); o1 = MFMA32(vb, pf, o1);
            }
            if (type == 0) wave_done = __all(carry < 9.0949470e-13f);
            else wave_done = __all((bound ? 0.f : qn) + fq2 - fkt[buf * 64] - mrun < -40.0f);
        }
        if (lane == 0) flags[buf * 8 + wid] = wave_done ? 1 : 0;
        if (kt >= 1) AT_LSTORE(buf ^ 1, buf ^ 1);
        __syncthreads();
        { int alld = 1;
#pragma unroll
            for (int w = 0; w < 8; ++w) alld &= flags[buf * 8 + w];
            if (alld) goto at_done; }
        if (--kt < 0) goto at_done;
      }
    }
at_done:
#undef AT_GLOAD
#undef AT_LSTORE
    if (wactive) {
        if (type == 1) { const float lt = lrun + __shfl_xor(lrun, 32); const float inv = 1.0f / lt;
#pragma unroll
            for (int r = 0; r < 16; ++r) { o0[r] *= inv; o1[r] *= inv; } }
        float sq = 0.f;
#pragma unroll
        for (int r = 0; r < 16; ++r) sq += o0[r] * o0[r] + o1[r] * o1[r];
        sq += __shfl_xor(sq, 32);
        if (hi == 0) ss[(size_t)qrow * 16] = sq;
        bf16_t* orow = O + (size_t)qrow * 1024 + 4 * hi;
#pragma unroll
        for (int g = 0; g < 4; ++g) {
            u32x2 w0, w1; w0.x = pk2(o0[4 * g], o0[4 * g + 1]); w0.y = pk2(o0[4 * g + 2], o0[4 * g + 3]); w1.x = pk2(o1[4 * g], o1[4 * g + 1]); w1.y = pk2(o1[4 * g + 2], o1[4 * g + 3]);
            *(u32x2*)(orow + 8 * g) = w0; *(u32x2*)(orow + 32 + 8 * g) = w1;
        }
    }
}

DI void transpose_item(const float* W, int K, int N, bf16_t* WT, int dst_row, int k0, int n0, LAS float* scr, int lane, const float* gk = nullptr, bool has_g = false) {
    float tv[32];
#pragma unroll
    for (int i = 0; i < 32; ++i) tv[i] = W[(size_t)(k0 + 2 * i + (lane >> 5)) * N + n0 + (lane & 31)];
    if (has_g) {
#pragma unroll
        for (int i = 0; i < 32; ++i) tv[i] *= gk[2 * i + (lane >> 5)]; }
#pragma unroll
    for (int i = 0; i < 32; ++i) scr[(2 * i + (lane >> 5)) * 33 + (lane & 31)] = tv[i];
    asm volatile("s_waitcnt lgkmcnt(0)" ::: "memory");
    const int c = lane & 7;
#pragma unroll
    for (int j = 0; j < 4; ++j) { const int n = (lane >> 3) + 8 * j; const LAS float* s = scr + (8 * c) * 33 + n;
        u32x4 o; o.x = pk2(s[0 * 33], s[1 * 33]); o.y = pk2(s[2 * 33], s[3 * 33]); o.z = pk2(s[4 * 33], s[5 * 33]); o.w = pk2(s[6 * 33], s[7 * 33]);
        *(u32x4*)(WT + (size_t)(dst_row + n) * K + k0 + 8 * c) = o; }
    asm volatile("s_waitcnt lgkmcnt(0)" ::: "memory");
}
DI void load_row(f32x4 (&v)[4], const float* x, int lane) {
    const f32x4* xr = (const f32x4*)x + lane;
#pragma unroll
    for (int j = 0; j < 4; ++j) v[j] = xr[64 * j];
}
DI void load_row_bf16(f32x4 (&v)[4], const bf16_t* x, int lane) {
#pragma unroll
    for (int j = 0; j < 4; ++j) { const u32x2 w = *(const u32x2*)(x + 4 * lane + 256 * j); v[j][0] = __uint_as_float(w.x << 16); v[j][1] = __uint_as_float(w.x & 0xffff0000u); v[j][2] = __uint_as_float(w.y << 16); v[j][3] = __uint_as_float(w.y & 0xffff0000u); }
}
DI void load_raw_bf16(u32x2 (&w)[4], const bf16_t* x, int lane) {
#pragma unroll
    for (int j = 0; j < 4; ++j) w[j] = *(const u32x2*)(x + 4 * lane + 256 * j);
}
DI void cvt_raw_bf16(f32x4 (&v)[4], const u32x2 (&w)[4]) {
#pragma unroll
    for (int j = 0; j < 4; ++j) { v[j][0] = __uint_as_float(w[j].x << 16); v[j][1] = __uint_as_float(w[j].x & 0xffff0000u); v[j][2] = __uint_as_float(w[j].y << 16); v[j][3] = __uint_as_float(w[j].y & 0xffff0000u); }
}
DI void add_parts(f32x4 (&v)[4], const float* pA, const float* pB, int S, int srow, const float* gate, int lane) {
#pragma unroll
    for (int j = 0; j < 4; ++j) { const int c = 4 * lane + 256 * j; f32x4 sum = {0.f, 0.f, 0.f, 0.f};
        for (int sp = 0; sp < S; ++sp) sum += *(const f32x4*)((sp < 8 ? pA + (size_t)sp * 1048576 : pB + (size_t)(sp - 8) * 1048576) + (size_t)srow * 1024 + c);
        v[j] += (*(const f32x4*)(gate + c) + 1.0f) * sum; }
}
DI void add_parts6(f32x4 (&v)[4], const float* pA, int srow, const float* gate, float r_sb, float r_fx, int lane) {
#pragma unroll
    for (int j = 0; j < 4; ++j) { const int c = 4 * lane + 256 * j; f32x4 sa = {0.f, 0.f, 0.f, 0.f}, sb = {0.f, 0.f, 0.f, 0.f};
#pragma unroll
        for (int sp = 0; sp < 4; ++sp) { sa += *(const f32x4*)(pA + (size_t)sp * 1048576 + (size_t)srow * 1024 + c); sb += *(const f32x4*)(pA + (size_t)(sp + 4) * 1048576 + (size_t)srow * 1024 + c); }
        v[j] += (*(const f32x4*)(gate + c) + 1.0f) * (sa * r_sb + sb * r_fx); }
}
DI float row_rstd(const f32x4 (&v)[4]) {
    float s = 0.f;
#pragma unroll
    for (int j = 0; j < 4; ++j) s += (v[j][0] * v[j][0] + v[j][1] * v[j][1]) + (v[j][2] * v[j][2] + v[j][3] * v[j][3]);
    return 1.0f / sqrtf(wave_sum(s) * (1.0f / 1024.0f) + EPS);
}
DI void norm_store_bf16(const f32x4 (&v)[4], const float* g, const float* scale, const float* shift, bf16_t* o, int lane) {
    const float rstd = row_rstd(v);
#pragma unroll
    for (int j = 0; j < 4; ++j) { const int c = 4 * lane + 256 * j; const f32x4 gv = *(const f32x4*)(g + c), sc = *(const f32x4*)(scale + c), sh = *(const f32x4*)(shift + c);
        const f32x4 r = (v[j] * rstd * gv) * (sc + 1.0f) + sh; u32x2 w; w.x = pk2(r[0], r[1]); w.y = pk2(r[2], r[3]); *(u32x2*)(o + c) = w; }
}
DI void norm_store_f32(const f32x4 (&v)[4], const float* g, float* o, int lane) {
    const float rstd = row_rstd(v);
#pragma unroll
    for (int j = 0; j < 4; ++j) { const int c = 4 * lane + 256 * j; const f32x4 gv = *(const f32x4*)(g + c); *(f32x4*)(o + c) = v[j] * rstd * gv; }
}

struct Args { const float* in[22]; float* out; unsigned char* ws; int ph_lo, ph_hi; };
enum { I_XP = 0, I_XS, I_CP, I_CS, I_CSBK, I_CSBV, I_CFXK, I_CFXV, I_CLF, I_WADA, I_BADA, I_GMIX, I_WIN, I_BF, I_GSB, I_GFX, I_WO, I_GFFN, I_WG, I_WU, I_WD, I_GFIN };
constexpr int NPHASE = 11;

__global__ void __launch_bounds__(512, 2) mk_fwd(Args a) {
    extern __shared__ __attribute__((aligned(16))) unsigned char lds_raw[];
    LAS unsigned char* lds = (LAS unsigned char*)lds_raw;
    cg::grid_group grid = cg::this_grid();
    const int tid = threadIdx.x, lane = tid & 63, wave = __builtin_amdgcn_readfirstlane(tid >> 6);
    const int G = gridDim.x, bid = blockIdx.x;
    const int gw = bid * 8 + wave, NGW = G * 8;
    unsigned char* ws = a.ws; float* out = a.out;
    float* ada = (float*)(ws + WS_ADA); float* fcp = (float*)(ws + WS_FCP); float* fcs = (float*)(ws + WS_FCS); float* ssb = (float*)(ws + WS_SS);
    bf16_t* WinT = (bf16_t*)(ws + WS_WIN); bf16_t* WoT = (bf16_t*)(ws + WS_WO); bf16_t* WguT = (bf16_t*)(ws + WS_WGU); bf16_t* WdT = (bf16_t*)(ws + WS_WD);
    bf16_t* Hn = (bf16_t*)(ws + WS_HN); bf16_t* Qb = (bf16_t*)(ws + WS_QB); bf16_t* Kp = (bf16_t*)(ws + WS_KP); bf16_t* Vp = (bf16_t*)(ws + WS_VP);
    bf16_t* Ks = (bf16_t*)(ws + WS_KS); bf16_t* Vs = (bf16_t*)(ws + WS_VS); bf16_t* Hff = (bf16_t*)(ws + WS_HFF); bf16_t* X1 = (bf16_t*)(ws + WS_X1);
    unsigned* kmax2 = (unsigned*)(ws + WS_KMAX); unsigned* uctr = (unsigned*)(ws + WS_CTR);
    float* part6 = (float*)(ws + 100 * MiB);
    float* part9a = (float*)(ws + WS_HN); float* part9b = (float*)(ws + 160 * MiB);
    const int lo = a.ph_lo, hi_ph = a.ph_hi;
#define IN(k) (lo <= (k) && (k) < hi_ph)
#ifndef REP_SYNC
#define REP_SYNC 1
#endif
#define SEAM(k) do { if (IN(k) && IN((k) + 1)) { for (int rs_ = 0; rs_ < REP_SYNC; ++rs_) xcd_barrier(xbar); } } while (0)
    LAS unsigned* misc = (LAS unsigned*)(lds + 131072);
    if (tid < 16) misc[tid] = 0u;
    __syncthreads();
    XcdBarrier xbar = xcd_barrier_post((unsigned*)(ws + WS_BAR), (volatile LAS unsigned*)(misc + 8));
    if (lo < 0) grid.sync();

    if (IN(0)) {
        for (int cb = bid; cb < 192; cb += G) {
            LAS float* sil = (LAS float*)lds;
            LAS float* red = (LAS float*)(lds + 73728);
            for (int i = tid; i < 18 * 1024; i += 512) { const int b = i >> 10, k = i & 1023; const float c = b < 2 ? a.in[I_CP][b * 1024 + k] : a.in[I_CS][(b - 2) * 1024 + k]; sil[i] = c / (1.0f + expf(-c)); }
            __syncthreads();
            const int kg = tid >> 3, c4 = tid & 7, col0 = cb * 32;
            f32x4 acc[18];
#pragma unroll
            for (int b = 0; b < 18; ++b) acc[b] = (f32x4){0.f, 0.f, 0.f, 0.f};
            const float* wp = a.in[I_WADA] + (size_t)kg * 6144 + col0 + 4 * c4;
#pragma unroll 2
            for (int i = 0; i < 16; ++i) { const f32x4 w4 = *(const f32x4*)(wp + (size_t)i * 64 * 6144); const int k = kg + 64 * i;
#pragma unroll
                for (int b = 0; b < 18; ++b) acc[b] += w4 * sil[b * 1024 + k]; }
#pragma unroll
            for (int b = 0; b < 18; ++b)
#pragma unroll
                for (int e = 0; e < 4; ++e) { float v = acc[b][e]; v += __shfl_xor(v, 8); v += __shfl_xor(v, 16); v += __shfl_xor(v, 32); acc[b][e] = v; }
            if (lane < 8) {
#pragma unroll
                for (int b = 0; b < 18; ++b) *(LAS f32x4*)(red + ((wave * 8 + lane) * 18 + b) * 4) = acc[b]; }
            __syncthreads();
            for (int o = tid; o < 18 * 32; o += 512) { const int b = o >> 5, c = o & 31; float sum = a.in[I_BADA][col0 + c];
#pragma unroll
                for (int w = 0; w < 8; ++w) sum += red[((w * 8 + (c >> 2)) * 18 + b) * 4 + (c & 3)];
                ada[(size_t)b * 6144 + col0 + c] = sum; }
            __syncthreads();
        }
        {
            LAS float* scr = (LAS float*)(lds + 8192 + wave * 8448);
            for (int it = gw; it < 16 * 96; it += NGW) { const int kb = it / 96, nb = it % 96; transpose_item(a.in[I_WIN], 1024, NIN, WinT, nb * 32, kb * 64, nb * 32, scr, lane); }
            for (int i = bid * 512 + tid; i < 8 * 1024; i += G * 512) { const int j = i >> 10, k = i & 1023; const float w = a.in[I_WIN][(size_t)k * NIN + 3072 + j];
                WinT[(size_t)(3072 + j) * 1024 + k] = (bf16_t)(pk2(w, 0.f) & 0xffffu); }
        }
    }
    SEAM(0);
    if (IN(1)) {
        int ln = lane; asm volatile("" : "+v"(ln));
        {
            f32x4 S0[4], S1[4], S2[4], S3[4]; int r = gw;
#define P1_LD(S, k) load_row(S, a.in[I_XP] + (size_t)min(r + (k) * NGW, MP - 1) * 1024, ln)
#define P1_DO(S, k) do { const int row = min(r + (k) * NGW, MP - 1); const float* ad = ada + (size_t)(row >> 13) * 6144; norm_store_bf16(S, a.in[I_GMIX], ad + 1024, ad, Hn + (size_t)row * 1024, ln); } while (0)
            P1_LD(S0, 0); P1_LD(S1, 1); P1_LD(S2, 2); P1_LD(S3, 3);
            for (; r < MP; r += 4 * NGW) { P1_DO(S0, 0); P1_LD(S0, 4); P1_DO(S1, 1); P1_LD(S1, 5); P1_DO(S2, 2); P1_LD(S2, 6); P1_DO(S3, 3); P1_LD(S3, 7); }
#undef P1_LD
#undef P1_DO
        }
        for (int row = MP + gw; row < M; row += NGW) { const float* ad = ada + (size_t)row_batch(row) * 6144;
            f32x4 v[4]; load_row(v, a.in[I_XS] + (size_t)(row - MP) * 1024, ln); norm_store_bf16(v, a.in[I_GMIX], ad + 1024, ad, Hn + (size_t)row * 1024, ln); }
    }
    SEAM(1);
    if (IN(2)) {
        pg8::Gemm g{Hn, WinT, M, NINP, 1024}; pg8::StaticOrder S; S.init(M, NINP, G, bid, 1024);
        EpiIn E{out, Qb, ws, a.in[I_BF]};
        pg8::gemm_phase<EpiIn, pg8::StaticOrder, true, true>(lds, g, S, E);
        {
            const int rem = S.nwg % G, nidle = rem ? G - rem : G, iw = rem ? bid - rem : bid;
            if (iw >= 0) {
                __syncthreads();
                LAS float* scr = (LAS float*)(lds + wave * 8448);
                constexpr int I_O = 16 * 32, I_G = 16 * 88, I_D = 44 * 32, NIT = I_O + 2 * I_G + I_D;
                for (int it = iw * 8 + wave; it < NIT; it += nidle * 8) {
                    int r = it;
                    if (r < I_O) { const int kb = r / 32, nb = r % 32; transpose_item(a.in[I_WO], 1024, 1024, WoT, nb * 32, kb * 64, nb * 32, scr, lane, kb < 8 ? a.in[I_GSB] + kb * 64 : a.in[I_GFX] + (kb - 8) * 64, true); continue; } r -= I_O;
                    if (r < I_G) { const int kb = r / 88, nb = r % 88, n0 = nb * 32; transpose_item(a.in[I_WG], 1024, DFF, WguT, 256 * (n0 >> 7) + (n0 & 127), kb * 64, n0, scr, lane); continue; } r -= I_G;
                    if (r < I_G) { const int kb = r / 88, nb = r % 88, n0 = nb * 32; transpose_item(a.in[I_WU], 1024, DFF, WguT, 256 * (n0 >> 7) + 128 + (n0 & 127), kb * 64, n0, scr, lane); continue; } r -= I_G;
                    { const int kb = r / 32, nb = r % 32; transpose_item(a.in[I_WD], DFF, 1024, WdT, nb * 32, kb * 64, nb * 32, scr, lane); }
                }
            }
        }
    }
    SEAM(2);
    if (IN(3)) {
        LAS float* sm = (LAS float*)lds; LAS float* sm2 = sm + 128;
        for (int job = bid; job < 144 + 256; job += G) {
            if (job < 144) {
                const bool pr = job < 64; int b, c; if (pr) { b = job >> 5; c = job & 31; } else { const int j = job - 64; b = j / 5; c = j - 5 * b; }
                const float* srcA = pr ? out + O_LFP + (size_t)b * TP * 8 : a.in[I_CLF] + (size_t)b * 1024 * 8;
                f32x4 ps = {0.f, 0.f, 0.f, 0.f};
                const f32x4* s4 = (const f32x4*)srcA;
                for (int i0 = 0; i0 < c; i0 += 8) {
                    f32x4 t[8];
#pragma unroll
                    for (int j = 0; j < 8; ++j) { t[j] = (f32x4){0.f, 0.f, 0.f, 0.f}; if (i0 + j < c) t[j] = s4[tid + 512 * (i0 + j)]; }
                    ps += ((t[0] + t[1]) + (t[2] + t[3])) + ((t[4] + t[5]) + (t[6] + t[7])); }
#pragma unroll
                for (int off = 2; off < 64; off <<= 1) { ps[0] += __shfl_xor(ps[0], off); ps[1] += __shfl_xor(ps[1], off); ps[2] += __shfl_xor(ps[2], off); ps[3] += __shfl_xor(ps[3], off); }
                if (lane < 2) *(LAS f32x4*)(sm + (wave * 2 + lane) * 4) = ps;
                const int nrows = (pr || c < 4) ? 256 : 64;
                float v[8];
#pragma unroll
                for (int e = 0; e < 8; ++e) v[e] = 0.f;
                if (tid < nrows) { const float* rp = (pr || c < 4) ? srcA + (size_t)(256 * c + tid) * 8 : out + O_LFS + ((size_t)b * 64 + tid) * 8;
                    const f32x4 v0 = *(const f32x4*)rp, v1 = *(const f32x4*)(rp + 4); v[0] = v0[0]; v[1] = v0[1]; v[2] = v0[2]; v[3] = v0[3]; v[4] = v1[0]; v[5] = v1[1]; v[6] = v1[2]; v[7] = v1[3]; }
#pragma unroll
                for (int off = 1; off < 64; off <<= 1) {
#pragma unroll
                    for (int e = 0; e < 8; ++e) { const float n = __shfl_up(v[e], off); if (lane >= off) v[e] += n; } }
                if (lane == 63) {
#pragma unroll
                    for (int e = 0; e < 8; ++e) sm2[wave * 8 + e] = v[e]; }
                __syncthreads();
#pragma unroll
                for (int e = 0; e < 8; ++e) { float p = 0.f;
#pragma unroll
                    for (int w = 0; w < 8; ++w) p += sm[(w * 2 + (e >> 2)) * 4 + (e & 3)];
                    for (int w = 0; w < wave; ++w) p += sm2[w * 8 + e];
                    v[e] += p; }
                if (tid < nrows) { float* dp = (pr ? fcp + ((size_t)b * TP + 256 * c + tid) * 8 : fcs + ((size_t)b * TS + 256 * c + tid) * 8);
                    *(f32x4*)dp = (f32x4){v[0], v[1], v[2], v[3]}; *(f32x4*)(dp + 4) = (f32x4){v[4], v[5], v[6], v[7]}; }
                __syncthreads();
            } else {
                const int jb = job - 144, row = jb * 64 + (tid >> 3), h = tid & 7;
                const u32x4* kp = (const u32x4*)(Kp + (size_t)row * 1024 + 512 + h * 64);
                float sq = 0.f;
#pragma unroll
                for (int i = 0; i < 8; ++i) { const u32x4 w = kp[i];
                    const float f0 = __uint_as_float(w.x << 16), f1 = __uint_as_float(w.x & 0xffff0000u), f2 = __uint_as_float(w.y << 16), f3 = __uint_as_float(w.y & 0xffff0000u);
                    const float f4 = __uint_as_float(w.z << 16), f5 = __uint_as_float(w.z & 0xffff0000u), f6 = __uint_as_float(w.w << 16), f7 = __uint_as_float(w.w & 0xffff0000u);
                    sq += (f0 * f0 + f1 * f1) + (f2 * f2 + f3 * f3) + (f4 * f4 + f5 * f5) + (f6 * f6 + f7 * f7); }
                sq = fmaxf(sq, __shfl_xor(sq, 8)); sq = fmaxf(sq, __shfl_xor(sq, 16)); sq = fmaxf(sq, __shfl_xor(sq, 32));
                if (lane < 8) atomicMax(kmax2 + (row >> 13) * 8 + lane, __float_as_uint(sq));
            }
        }
    }
    SEAM(3);
    if (IN(4)) for (int rep = 0; rep < REP_ATT; ++rep) {
        if (rep) { xcd_barrier(xbar); if (bid == 0 && tid == 0) __hip_atomic_store(uctr, 0u, __ATOMIC_RELAXED, __HIP_MEMORY_SCOPE_AGENT); xcd_barrier(xbar); }
        LAS int* uslot = (LAS int*)(lds + 4 * TILE_B + 1024);
        for (int first = 1;; first = 0) {
            int u = bid;
            if (!first) {
                if (tid == 0) *uslot = (int)atomicAdd(uctr, 1u) + G;
                __syncthreads();
                u = __builtin_amdgcn_readfirstlane(*uslot);
                __syncthreads();
            }
            if (u >= 1280) break;
            int type, b, h, qb = 0; bool samp = false;
            if (u < 512) { type = 1; qb = 31 - (u >> 4); b = (u >> 3) & 1; h = u & 7; }
            else if (u < 640) { const int w = u - 512; samp = true; type = 1; b = w >> 3; h = w & 7; }
            else if (u < 1152) { const int w = u - 640; type = 0; qb = 31 - (w >> 4); b = (w >> 3) & 1; h = w & 7; }
            else { const int w = u - 1152; samp = true; type = 0; b = w >> 3; h = w & 7; }
            const int colo = type * 512 + h * 64;
            const size_t rb = (size_t)b * TP, q0 = samp ? (size_t)MP + (size_t)b * 64 : rb + (size_t)qb * 256, kb = (size_t)b * TS;
            const bf16_t* Kb_ = samp ? Ks + (size_t)b * 64 * 1024 + colo : Kp + rb * 1024 + colo;
            const bf16_t* Vb_ = samp ? Vs + (size_t)b * 64 * 1024 + colo : Vp + rb * 1024 + colo;
            const float* cK = nullptr; const float* cV = nullptr;
            if (samp) { cK = (type ? a.in[I_CFXK] : a.in[I_CSBK]) + (size_t)b * 1024 * 512 + h * 64; cV = (type ? a.in[I_CFXV] : a.in[I_CSBV]) + (size_t)b * 1024 * 512 + h * 64; }
            const float kmn = (!samp && type == 1) ? sqrtf(__uint_as_float(kmax2[b * 8 + h])) : INFINITY;
            const float* fqp = samp ? fcs + (kb + 1024) * 8 + h : fcp + q0 * 8 + h; const float* fkp = samp ? fcs + kb * 8 + h : fcp + rb * 8 + h;
            attn_unit(lds, type, Qb + q0 * 1024 + colo, Kb_, Vb_, cK, cV, Hn + q0 * 1024 + colo, ssb + q0 * 16 + type * 8 + h, fqp, fkp, samp ? 1024 : qb * 256, samp ? 64 : 256, kmn);
        }
    }
    SEAM(4);
    if (IN(6)) {
        pg8::Gemm g{Hn, WoT, M, 1024, 1024}; TailOrder S; S.init(G, bid, 1024, 8);
        EpiRes<true> E{a.in[I_XP], ada, 2048, X1, 0, part6, part6, ssb};
        pg8::gemm_phase<EpiRes<true>, TailOrder, true, true>(lds, g, S, E);
    }
    SEAM(6);
    if (IN(7)) {
        int ln = lane; asm volatile("" : "+v"(ln));
        {
            u32x2 S0[4], S1[4], S2[4], S3[4]; int r = gw;
#define P7_LD(S, k) load_raw_bf16(S, X1 + (size_t)min(r + (k) * NGW, MP - 1) * 1024, ln)
#define P7_DO(S, k) do { const int row = min(r + (k) * NGW, MP - 1); const float* ad = ada + (size_t)(row >> 13) * 6144; f32x4 v[4]; cvt_raw_bf16(v, S); norm_store_bf16(v, a.in[I_GFFN], ad + 4096, ad + 3072, Hn + (size_t)row * 1024, ln); } while (0)
            P7_LD(S0, 0); P7_LD(S1, 1); P7_LD(S2, 2); P7_LD(S3, 3);
            for (; r < MP; r += 4 * NGW) { P7_DO(S0, 0); P7_LD(S0, 4); P7_DO(S1, 1); P7_LD(S1, 5); P7_DO(S2, 2); P7_LD(S2, 6); P7_DO(S3, 3); P7_LD(S3, 7); }
#undef P7_LD
#undef P7_DO
        }
        for (int row = MP + gw; row < M; row += NGW) { const float* ad = ada + (size_t)row_batch(row) * 6144;
            f32x4 v[4]; load_row(v, a.in[I_XS] + (size_t)(row - MP) * 1024, ln); float r_sb, r_fx; row_rstd2(ssb, row, r_sb, r_fx); add_parts6(v, part6, row - MP, ad + 2048, r_sb, r_fx, ln);
#pragma unroll
            for (int j = 0; j < 4; ++j) { u32x2 w; w.x = pk2(v[j][0], v[j][1]); w.y = pk2(v[j][2], v[j][3]); *(u32x2*)(X1 + (size_t)row * 1024 + 4 * ln + 256 * j) = w; }
            norm_store_bf16(v, a.in[I_GFFN], ad + 4096, ad + 3072, Hn + (size_t)row * 1024, ln); }
    }
    SEAM(7);
    if (IN(8)) {
        pg8::Gemm g{Hn, WguT, M, 2 * DFF, 1024}; pg8::StaticOrder S; S.init(M, 2 * DFF, G, bid, 1024);
        EpiUp E{Hff};
        pg8::gemm_phase<EpiUp, pg8::StaticOrder, true, true>(lds, g, S, E);
    }
    SEAM(8);
    if (IN(9)) {
        pg8::Gemm g{Hff, WdT, M, 1024, DFF}; TailOrder S; S.init(G, bid, DFF, 11);
        EpiRes<false> E{a.in[I_XP], ada, 5120, X1, 1, part9a, part9b, ssb};
        pg8::gemm_phase<EpiRes<false>, TailOrder, true, true>(lds, g, S, E);
    }
    SEAM(9);
    if (IN(10)) {
        int ln = lane; asm volatile("" : "+v"(ln));
        {
            u32x2 S0[4], S1[4], S2[4], S3[4]; int r = gw;
#define P10_LD(S, k) load_raw_bf16(S, X1 + (size_t)min(r + (k) * NGW, MP - 1) * 1024, ln)
#define P10_DO(S, k) do { const int row = min(r + (k) * NGW, MP - 1); f32x4 v[4]; cvt_raw_bf16(v, S); norm_store_f32(v, a.in[I_GFIN], out + O_YP + (size_t)row * 1024, ln); } while (0)
            P10_LD(S0, 0); P10_LD(S1, 1); P10_LD(S2, 2); P10_LD(S3, 3);
            for (; r < MP; r += 4 * NGW) { P10_DO(S0, 0); P10_LD(S0, 4); P10_DO(S1, 1); P10_LD(S1, 5); P10_DO(S2, 2); P10_LD(S2, 6); P10_DO(S3, 3); P10_LD(S3, 7); }
#undef P10_LD
#undef P10_DO
        }
        for (int row = MP + gw; row < M; row += NGW) { f32x4 v[4]; load_row_bf16(v, X1 + (size_t)row * 1024, ln);
            add_parts(v, part9a, part9b, 11, row - MP, ada + (size_t)row_batch(row) * 6144 + 5120, ln);
            norm_store_f32(v, a.in[I_GFIN], out + O_YS + (size_t)(row - MP) * 1024, ln); }
    }
#undef IN
#undef SEAM
}
}

extern "C" void kernel_launch(void* const* d_in, const int* in_sizes, int n_in, void* d_out, int out_size, void* d_ws, size_t ws_size, hipStream_t stream) {
    using namespace mk;
    static int grid = 0;
    if (grid == 0) {
        int dev = 0, cus = 0, per_cu = 0;
        (void)hipGetDevice(&dev); (void)hipDeviceGetAttribute(&cus, hipDeviceAttributeMultiprocessorCount, dev);
        if (hipFuncSetAttribute((const void*)mk_fwd, hipFuncAttributeMaxDynamicSharedMemorySize, LDS_BYTES) != hipSuccess) { fprintf(stderr, "kernel_launch: hipFuncSetAttribute failed\n"); grid = -1; return; }
        if (hipOccupancyMaxActiveBlocksPerMultiprocessor(&per_cu, (const void*)mk_fwd, 512, LDS_BYTES) != hipSuccess || per_cu < 1) { fprintf(stderr, "kernel_launch: occupancy query gave %d\n", per_cu); per_cu = 1; }
        (void)hipGetLastError();
        grid = cus * 1;
        if (grid <= 0) grid = 256;
    }
    if (grid < 0) return;
    (void)hipMemsetAsync((char*)d_ws + WS_BAR, 0, CTL_BYTES - WS_BAR, stream);
    Args a{};
    for (int i = 0; i < 22; ++i) a.in[i] = (const float*)d_in[i];
    a.out = (float*)d_out; a.ws = (unsigned char*)d_ws;
#if MK_MULTI
    for (int p = 0; p < NPHASE; ++p) { a.ph_lo = p; a.ph_hi = p + 1; hipLaunchKernelGGL(mk_fwd, dim3(grid), dim3(512), LDS_BYTES, stream, a); }
#else
    a.ph_lo = 0; a.ph_hi = NPHASE;
    void* args[] = {&a};
    hipError_t e = hipLaunchCooperativeKernel((const void*)mk_fwd, dim3(grid), dim3(512), args, LDS_BYTES, stream);
    if (e != hipSuccess) fprintf(stderr, "cooperative launch failed: %s (grid %d)\n", hipGetErrorString(e), grid);
#endif
}
```
